# Optimizing an MI355X kernel written in HIP

```python
import math
import jax, jax.numpy as jnp
from jax import lax
import numpy as np

D_MODEL = 4096
BATCH = 32
SEQ = 256
DEPTH = 1
DEC_BATCH = 8
DEC_SEQ = 4096
PAST_LEN = 512

GRID_W = 64
F_WIDTH = D_MODEL // 2
F_GROUPS = 4
F_GC = F_WIDTH // F_GROUPS
GLA_WIDTH = D_MODEL - F_WIDTH
GLA_HEADS = 4
GLA_DK_TOTAL = GLA_WIDTH // 2
GLA_DK = GLA_DK_TOTAL // GLA_HEADS
GLA_DV = GLA_WIDTH // GLA_HEADS
GLA_LOWRANK = 16
GLA_TAU = 16.0
GLA_CHUNK = 64
EPS = 1e-6
IN_SIZES = (F_WIDTH, F_WIDTH, GLA_DK_TOTAL, GLA_DK_TOTAL, GLA_WIDTH, GLA_WIDTH, GLA_LOWRANK, GLA_LOWRANK)
N_IN = sum(IN_SIZES)

kernel_name = "hymba_fnet_gla_diffusion_step"


def _split_offsets():
    offs, acc = [], 0
    for s in IN_SIZES[:-1]:
        acc += s
        offs.append(acc)
    return offs


def rmsnorm(x, w):
    xf = x.astype(jnp.float32)
    y = xf * lax.rsqrt(jnp.mean(xf * xf, axis=-1, keepdims=True) + EPS)
    return (y * w.astype(jnp.float32)).astype(x.dtype)


def fourier_mix(u, w_f, rows):
    B, L, _ = u.shape
    uf = u.astype(jnp.float32)
    if rows is None:
        spec = jnp.fft.fftn(uf.reshape(B, L, F_GROUPS, F_GC), axes=(1, 3), norm="ortho")
    else:
        spec = jnp.fft.fftn(uf.reshape(B, rows, GRID_W, F_GROUPS, F_GC), axes=(1, 2, 4), norm="ortho")
    re = jnp.real(spec).reshape(B, L, F_GROUPS, F_GC).astype(u.dtype)
    out = jnp.einsum('blgc,gcd->blgd', re, w_f)
    return out.reshape(B, L, F_WIDTH)


def gla_scan(q, k, v, g, s0):
    B, H, L, dk = q.shape
    dv = v.shape[-1]
    n = L // GLA_CHUNK

    def chunks(t):
        return jnp.moveaxis(t.reshape(B, H, n, GLA_CHUNK, t.shape[-1]), 2, 0)

    mask = jnp.tril(jnp.ones((GLA_CHUNK, GLA_CHUNK), dtype=bool))

    def step(S, inp):
        qc, kc, vc, gc = inp
        b = jnp.cumsum(gc, axis=-2)
        b_last = b[..., -1:, :]
        q_t = qc * jnp.exp(b)
        k_t = kc * jnp.exp(-b)
        o_inter = jnp.einsum('bhik,bhkv->bhiv', q_t, S)
        att = jnp.where(mask, jnp.einsum('bhik,bhjk->bhij', q_t, k_t), 0.0)
        o_intra = jnp.einsum('bhij,bhjv->bhiv', att, vc)
        k_dec = kc * jnp.exp(b_last - b)
        S_new = jnp.exp(b_last)[..., 0, :, None] * S + jnp.einsum('bhjk,bhjv->bhkv', k_dec, vc)
        return S_new.astype(S.dtype), (o_inter + o_intra).astype(vc.dtype)

    S_fin, o = lax.scan(step, s0, (chunks(q), chunks(k), chunks(v), chunks(g)))
    o = jnp.moveaxis(o, 0, 2).reshape(B, H, L, dv)
    return o, S_fin


def gla_bidir(q, k, v, g_f, g_b, s0_f, s0_b):
    o_f, s_f = gla_scan(q, k, v, g_f, s0_f)
    flip = lambda t: jnp.flip(t, axis=2)
    o_b, s_b = gla_scan(flip(q), flip(k), flip(v), flip(g_b), s0_b)
    return o_f + flip(o_b), s_f, s_b


def to_heads(t, d):
    B, L = t.shape[:2]
    return t.reshape(B, L, GLA_HEADS, d).transpose(0, 2, 1, 3)


def mixer_branch(h, w_in, w_alpha, b_alpha, w_fourier, gla_norm_w, w_out, rows, s0_f, s0_b):
    B, L, _ = h.shape
    proj = h @ w_in
    f_in, f_gate, q, k, v, g_gate, a_f, a_b = jnp.split(proj, _split_offsets(), axis=-1)
    f_out = fourier_mix(f_in, w_fourier, rows) * jax.nn.silu(f_gate)
    qh = to_heads(q, GLA_DK) * (GLA_DK ** -0.5)
    kh = to_heads(k, GLA_DK)
    vh = to_heads(v, GLA_DV)
    w32 = w_alpha.astype(jnp.float32)
    b32 = b_alpha.astype(jnp.float32)
    g_f = jax.nn.log_sigmoid(a_f.astype(jnp.float32) @ w32[0] + b32[0]) / GLA_TAU
    g_b = jax.nn.log_sigmoid(a_b.astype(jnp.float32) @ w32[1] + b32[1]) / GLA_TAU
    o, s_f, s_b = gla_bidir(qh, kh, vh, to_heads(g_f, GLA_DK), to_heads(g_b, GLA_DK), s0_f, s0_b)
    o = rmsnorm(o.transpose(0, 2, 1, 3), gla_norm_w)
    g_out = o.reshape(B, L, GLA_WIDTH) * jax.nn.silu(g_gate)
    out = jnp.concatenate([f_out, g_out], axis=-1) @ w_out
    return out, s_f, s_b


def setup_inputs(seed: int = 0) -> dict:
    key = jax.random.key(seed)
    ks = jax.random.split(key, 16)
    f32 = jnp.float32
    nrm = lambda k, shape, s: jax.random.normal(k, shape, f32) * s
    return {
        "x_prompt": nrm(ks[0], (BATCH, SEQ, D_MODEL), 1.0),
        "x_sample": nrm(ks[1], (DEC_BATCH, DEC_SEQ, D_MODEL), 1.0),
        "state_gla_fwd": nrm(ks[2], (DEC_BATCH, DEPTH, GLA_HEADS, GLA_DK, GLA_DV), 1.0),
        "state_gla_bwd": nrm(ks[3], (DEC_BATCH, DEPTH, GLA_HEADS, GLA_DK, GLA_DV), 1.0),
        "c": nrm(ks[4], (DEC_BATCH, D_MODEL), 1.0),
        "c_ctx": nrm(ks[5], (D_MODEL,), 1.0),
        "ada_w": nrm(ks[6], (DEPTH, D_MODEL, 3 * D_MODEL), D_MODEL ** -0.5),
        "ada_b": nrm(ks[7], (DEPTH, 3 * D_MODEL), 0.02),
        "norm_w": 1.0 + nrm(ks[8], (DEPTH, D_MODEL), 0.02),
        "w_in": nrm(ks[9], (DEPTH, D_MODEL, N_IN), D_MODEL ** -0.5),
        "w_alpha": nrm(ks[10], (DEPTH, 2, GLA_LOWRANK, GLA_DK_TOTAL), GLA_LOWRANK ** -0.5),
        "b_alpha": nrm(ks[11], (DEPTH, 2, GLA_DK_TOTAL), 0.5),
        "w_fourier": nrm(ks[12], (DEPTH, F_GROUPS, F_GC, F_GC), F_GC ** -0.5),
        "gla_norm_w": 1.0 + nrm(ks[13], (DEPTH, GLA_HEADS, GLA_DV), 0.02),
        "w_out": nrm(ks[14], (DEPTH, D_MODEL, D_MODEL), D_MODEL ** -0.5),
        "final_norm_w": 1.0 + nrm(ks[15], (D_MODEL,), 0.02),
    }


def reference(x_prompt, x_sample, state_gla_fwd, state_gla_bwd, c, c_ctx, ada_w, ada_b, norm_w,
              w_in, w_alpha, b_alpha, w_fourier, gla_norm_w, w_out, final_norm_w):
    Bp = x_prompt.shape[0]
    rows = x_sample.shape[1] // GRID_W
    zeros_state = jnp.zeros((Bp, GLA_HEADS, GLA_DK, GLA_DV), dtype=x_prompt.dtype)
    xp, xs = x_prompt, x_sample
    new_f, new_b = [], []
    for l in range(DEPTH):
        mod_ctx = jax.nn.silu(c_ctx) @ ada_w[l] + ada_b[l]
        sh, sc, gt = jnp.split(mod_ctx, 3, axis=-1)
        h = rmsnorm(xp, norm_w[l]) * (1.0 + sc) + sh
        out, s_f, s_b = mixer_branch(h, w_in[l], w_alpha[l], b_alpha[l], w_fourier[l], gla_norm_w[l],
                                     w_out[l], None, zeros_state, zeros_state)
        xp = xp + gt * out
        new_f.append(s_f)
        new_b.append(s_b)
        mod = jax.nn.silu(c) @ ada_w[l] + ada_b[l]
        sh, sc, gt = jnp.split(mod[:, None, :], 3, axis=-1)
        h = rmsnorm(xs, norm_w[l]) * (1.0 + sc) + sh
        out, _, _ = mixer_branch(h, w_in[l], w_alpha[l], b_alpha[l], w_fourier[l], gla_norm_w[l],
                                 w_out[l], rows, state_gla_fwd[:, l], state_gla_bwd[:, l])
        xs = xs + gt * out
    y_prompt = rmsnorm(xp, final_norm_w)
    y_sample = rmsnorm(xs, final_norm_w)
    new_state_fwd = jnp.stack(new_f, axis=1)
    new_state_bwd = jnp.stack(new_b, axis=1)
    return (y_prompt, y_sample, new_state_fwd, new_state_bwd)
```

```cpp
#include <hip/hip_runtime.h>
#include <stdint.h>
#define LAS __attribute__((address_space(3)))
typedef unsigned short bf16_t;
typedef short bf16x8 __attribute__((ext_vector_type(8)));
typedef short bf16x4 __attribute__((ext_vector_type(4)));
typedef float f32x4 __attribute__((ext_vector_type(4)));
typedef float f32x2 __attribute__((ext_vector_type(2)));
typedef unsigned u32x4 __attribute__((ext_vector_type(4)));
typedef unsigned u32x2 __attribute__((ext_vector_type(2)));

constexpr int D = 4096, TC = 8192, TL = 32768, T = TC + TL, NIN = 10272, NINP = 10496;
constexpr int LDS_BYTES = 147456;
constexpr int LDS_BARW = 147456 - 16;
constexpr size_t WS_CTL = 0;
constexpr size_t WS_MODV = 16384;
constexpr size_t WS_ZERO_BYTES = 16384 + 9 * 12288 * 4;
constexpr size_t WS_H = 1u << 20;
constexpr size_t SZ_H = (size_t)T * 4096 * 2;
constexpr size_t WS_ZTC = WS_H;
constexpr size_t WS_ZTL = WS_H + (size_t)4 * 512 * 16384 * 2;
constexpr size_t WS_MIX = WS_H;
constexpr size_t WS_WINT = WS_H + SZ_H;
constexpr size_t WS_WOUTT = WS_WINT + (size_t)NINP * 4096 * 2;
constexpr size_t WS_WFT = WS_WOUTT + (size_t)4096 * 4096 * 2;
constexpr size_t WS_DCH = WS_WFT + (size_t)4 * 512 * 512 * 2;
constexpr size_t WS_PCTX = WS_DCH + (size_t)1024 * 512 * 2;
constexpr size_t WS_PLAT = WS_PCTX + (size_t)256 * 512 * 2;
constexpr size_t WS_FIN = WS_PLAT + (size_t)4096 * 8192 * 2;
constexpr size_t WS_RE = WS_FIN;
constexpr size_t WS_FGATE = WS_FIN + (size_t)T * 2048 * 2;
constexpr size_t WS_Q = WS_FGATE + (size_t)T * 2048 * 2;
constexpr size_t WS_K = WS_Q + (size_t)T * 1024 * 2;
constexpr size_t WS_V = WS_K + (size_t)T * 1024 * 2;
constexpr size_t WS_GG = WS_V + (size_t)T * 2048 * 2;
constexpr size_t WS_AB = WS_GG + (size_t)T * 2048 * 2;
constexpr size_t WS_OF = WS_AB + (size_t)T * 32 * 2;
constexpr size_t WS_OB = WS_OF + (size_t)T * 2048 * 2;
constexpr size_t WS_KDG = WS_OB + (size_t)T * 2048 * 2;
constexpr size_t WS_DECG = WS_KDG + (size_t)2 * T * 1024 * 2;
constexpr size_t WS_QTG = WS_FIN;
constexpr size_t WS_KTG = WS_FGATE;
constexpr size_t WS_END = WS_DECG + (size_t)2 * (T / 64) * 1024 * 4;

struct Args {
    const float* x_prompt; const float* x_sample; const float* st_f; const float* st_b; const float* c; const float* c_ctx;
    const float* ada_w; const float* ada_b; const float* norm_w; const float* w_in; const float* w_alpha; const float* b_alpha;
    const float* w_fourier; const float* gla_norm_w; const float* w_out; const float* final_norm_w;
    float* out; unsigned char* ws;
};

__device__ __forceinline__ unsigned cvt_pk_bf16(float lo, float hi) { unsigned r; asm volatile("v_cvt_pk_bf16_f32 %0, %1, %2" : "=v"(r) : "v"(lo), "v"(hi)); return r; }
__device__ __forceinline__ float bf2f(unsigned short b) { return __uint_as_float(((unsigned)b) << 16); }
__device__ __forceinline__ float bflo(unsigned w) { return __uint_as_float(w << 16); }
__device__ __forceinline__ float bfhi(unsigned w) { return __uint_as_float(w & 0xffff0000u); }
__device__ __forceinline__ float silu_f(float x) { return x / (1.0f + __expf(-x)); }
__device__ __forceinline__ float wave_sum(float v) {
#pragma unroll
    for (int o = 32; o >= 1; o >>= 1) v += __shfl_xor(v, o);
    return v; }

__device__ __forceinline__ int fresh_tid() { int t = threadIdx.x; asm volatile("" : "+v"(t)); return t; }
#define XB_TMO      128
#define XB_XCNT(j)  (256  + 64 * (j))
#define XB_XSUB(j)  (1280 + 64 * (j))
#define XB_XGEN(j)  (2304 + 64 * (j))
#define XB_TOP      3328
#define XB_TOPGEN   3392
#define XCD_BAR_WORDS 3456
#define XB_SPIN_CAP (1u << 18)
#define LAS __attribute__((address_space(3)))

__device__ __forceinline__ unsigned xb_ld(unsigned* p)              { return __hip_atomic_load(p, __ATOMIC_RELAXED, __HIP_MEMORY_SCOPE_AGENT); }
__device__ __forceinline__ unsigned xb_add(unsigned* p, unsigned v) { return __hip_atomic_fetch_add(p, v, __ATOMIC_RELAXED, __HIP_MEMORY_SCOPE_AGENT); }
__device__ __forceinline__ unsigned xb_xcc_id() { return (unsigned)__builtin_amdgcn_s_getreg((3 << 11) | 20) & 0xFu; }
#define XB_SPIN(cond, bar) do { unsigned _sp = 0; while (cond) { __builtin_amdgcn_s_sleep(1); \
    if ((++_sp & 255u) == 0u) { if (xb_ld(&(bar)[XB_TMO])) break; if (_sp > XB_SPIN_CAP) { atomicAdd(&(bar)[XB_TMO], 1u); break; } } } } while (0)

struct XcdBarrier {
    unsigned* bar; unsigned x;
    volatile LAS unsigned* st;
};

__device__ __forceinline__ XcdBarrier xcd_barrier_post(unsigned* bar, volatile LAS unsigned* st) {
    XcdBarrier b; b.bar = bar; b.x = xb_xcc_id(); b.st = st;
    if (threadIdx.x == 0) (void)xb_add(&bar[XB_XCNT(b.x)], 1u);
    return b;
}
__device__ __forceinline__ void xcd_barrier_complete(unsigned* bar, unsigned x, unsigned& nloc, unsigned& nx) {
    const unsigned G = gridDim.x * gridDim.y * gridDim.z;
    unsigned sum, cnt, mine, sp = 0u;
    for (;;) {
        sum = 0u; cnt = 0u; mine = 0u;
#pragma unroll
        for (unsigned j = 0; j < 16; ++j) { const unsigned c = xb_ld(&bar[XB_XCNT(j)]); sum += c; cnt += (c > 0u) ? 1u : 0u; mine = (j == x) ? c : mine; }
        if (sum == G) break;
        __builtin_amdgcn_s_sleep(1);
        if ((++sp & 255u) == 0u) { if (xb_ld(&bar[XB_TMO])) break; if (sp > XB_SPIN_CAP) { atomicAdd(&bar[XB_TMO], 1u); break; } }
    }
    nloc = mine > 0u ? mine : 1u; nx = cnt > 0u ? cnt : 1u;
}

__device__ __forceinline__ void xcd_barrier(const XcdBarrier& b) {
    asm volatile("s_waitcnt vmcnt(0)" ::: "memory");
    __syncthreads();
    if (threadIdx.x == 0) {
        unsigned* bar = b.bar;
        __builtin_amdgcn_s_waitcnt(0);
        unsigned nloc = b.st[0], nx = b.st[1];
        if (nloc == 0u) { xcd_barrier_complete(bar, b.x, nloc, nx); b.st[0] = nloc; b.st[1] = nx; }
        const unsigned old = xb_add(&bar[XB_XSUB(b.x)], 1u);
        const unsigned gen = old / nloc;
        if (old + 1u == (gen + 1u) * nloc) {
            __builtin_amdgcn_fence(__ATOMIC_RELEASE, "agent");
            asm volatile("s_waitcnt vmcnt(0)" ::: "memory");
            const unsigned og = xb_add(&bar[XB_TOP], 1u);
            const unsigned tg = og / nx;
            if (og + 1u == (tg + 1u) * nx) xb_add(&bar[XB_TOPGEN], 1u);
            else XB_SPIN(xb_ld(&bar[XB_TOPGEN]) == tg, bar);
            __builtin_amdgcn_fence(__ATOMIC_ACQUIRE, "agent");
            xb_add(&bar[XB_XGEN(b.x)], 1u);
            asm volatile("s_waitcnt vmcnt(0)" ::: "memory");
        } else {
            XB_SPIN(xb_ld(&bar[XB_XGEN(b.x)]) == gen, bar);
            __builtin_amdgcn_fence(__ATOMIC_ACQUIRE, "agent");
            asm volatile("s_waitcnt vmcnt(0)" ::: "memory");
        }
    }
    __syncthreads();
}

namespace pg8 {
#define PG8_LAS __attribute__((address_space(3)))
constexpr int BM = 256, BK = 64, HALF = 128, HTB = HALF * BK * 2, STAGE_BYTES = 8 * HTB, NXCD = 8, WGM = 8;
__host__ __device__ __forceinline__ int lds_byte(int r, int c) { const int st = (r >> 4) * 2 + (c >> 5), rr = r & 15, cc = c & 31, ob = rr * 64 + cc * 2; return st * 1024 + (ob ^ (((ob >> 9) & 1) << 5)); }
__host__ __device__ __forceinline__ void stage_rc(int b, int& R, int& C) { const int st = b / 1024, sb = b % 1024, swz = sb ^ (((sb >> 9) & 1) << 5); R = (st >> 1) * 16 + swz / 64; C = (st & 1) * 32 + (swz % 64) / 2; }
__host__ __device__ __forceinline__ int perm32(int rho) { const int n = rho >> 4, i = rho & 15; return 8 * (i >> 2) + 4 * n + (i & 3); }
struct Unit { const char* a; const char* b; int pm, pn, bz; };
struct BOrder {
    int nM, nN, nB, nB2, G, c, nsplit; const char* A; const char* B; size_t sA1, sA2, sB1, sB2, tA, tB, aN, bM;
    __device__ __forceinline__ bool next(int i, Unit& u) const {
        const long L = (long)i * G + c; const int nwg = nB * nM * nN; if (L >= nwg) return false;
        int wgid = (int)L; { const int q = nwg / NXCD, r = nwg % NXCD, xcd = wgid % NXCD, off = wgid / NXCD; wgid = (xcd < r ? xcd * (q + 1) : r * (q + 1) + (xcd - r) * q) + off; }
        const int per = nM * nN, bz = wgid / per; wgid -= bz * per;
        const int nig = WGM * nN, gid = wgid / nig, fm = gid * WGM, gsz = (nM - fm) < WGM ? (nM - fm) : WGM;
        u.pm = fm + ((wgid % nig) % gsz); u.pn = (wgid % nig) / gsz; u.bz = bz;
        const int b1 = bz / nB2, b2 = bz % nB2;
        u.a = A + (size_t)b1 * sA1 + (size_t)b2 * sA2 + (size_t)u.pm * tA + (size_t)(u.pn / nsplit) * aN; u.b = B + (size_t)b1 * sB1 + (size_t)b2 * sB2 + (size_t)(u.pn % nsplit) * tB + (size_t)u.pm * bM; return true;
    }
};
template <class Epi, class Sched>
__device__ __forceinline__ void gemm_phase(PG8_LAS unsigned char* lds, const int lda, const int ldb, const int K, const Sched& S, const Epi& E) {
    const int tid = fresh_tid(), wid = __builtin_amdgcn_readfirstlane(tid >> 6), lane = tid & 63, wr = wid >> 2, wc = wid & 3, fr = lane & 15, fq = lane >> 4;
    const int nt = K / BK;
    unsigned voffA[2], voffB[2];
#pragma unroll
    for (int i = 0; i < 2; ++i) { int R, C; stage_rc(tid * 16 + i * 8192, R, C); const int Rb = Epi::PERM ? ((R & ~31) + perm32(R & 31)) : R;
        voffA[i] = (unsigned)(R * lda + C) * 2u; voffB[i] = (unsigned)(Rb * ldb + C) * 2u; }
    const size_t kstep = (size_t)(BK * 2);
    const size_t hsA = (size_t)HALF * lda * 2, hsB = (size_t)HALF * ldb * 2;
    const unsigned ldsw = (unsigned)wid * 1024u;
    const int aoff = lds_byte(wr * 64 + fr, fq * 8), boff = lds_byte(wc * 32 + fr, fq * 8);
#define PG8_SA(b, h) (((b) * 2 + (h)) * HTB)
#define PG8_SB(b, h) ((4 + (b) * 2 + (h)) * HTB)
#define PG8_STAGE(bufoff, gbase, voff) do { _Pragma("unroll") for (int _i = 0; _i < 2; ++_i) \
        __builtin_amdgcn_global_load_lds((const unsigned*)((const char*)(gbase) + (voff)[_i]), (PG8_LAS unsigned*)(lds + (bufoff) + ldsw + _i * 8192), 16, 0, 0); } while (0)
#define PG8_LDA(dst, b, h) do { _Pragma("unroll") for (int m = 0; m < 4; ++m) _Pragma("unroll") for (int k = 0; k < 2; ++k) dst[m][k] = *(const PG8_LAS bf16x8*)(lds + PG8_SA(b, h) + aoff + m * 2048 + k * 1024); } while (0)
#define PG8_LDB(dst, b, h) do { _Pragma("unroll") for (int n = 0; n < 2; ++n) _Pragma("unroll") for (int k = 0; k < 2; ++k) dst[n][k] = *(const PG8_LAS bf16x8*)(lds + PG8_SB(b, h) + boff + n * 2048 + k * 1024); } while (0)
#define PG8_MMA(ai, bj, At, Bt) do { __builtin_amdgcn_s_setprio(1); _Pragma("unroll") for (int m = 0; m < 4; ++m) _Pragma("unroll") for (int n = 0; n < 2; ++n) _Pragma("unroll") for (int k = 0; k < 2; ++k) \
        acc[ai][bj][m][n] = __builtin_amdgcn_mfma_f32_16x16x32_bf16(Bt[n][k], At[m][k], acc[ai][bj][m][n], 0, 0, 0); __builtin_amdgcn_s_setprio(0); } while (0)
#define PG8_WAIT_V(n) asm volatile("s_waitcnt vmcnt(" #n ")" ::: "memory")
#define PG8_WAIT_L(n) asm volatile("s_waitcnt lgkmcnt(" #n ")" ::: "memory")
#define PG8_BAR __builtin_amdgcn_s_barrier()
#define PG8_SCHED __builtin_amdgcn_sched_barrier(0)
    Unit cur, nxt; int ui = 0;
    if (!S.next(0, cur)) return;
    f32x4 acc[2][2][4][2];
#pragma unroll
    for (int a = 0; a < 2; ++a)
#pragma unroll
        for (int b = 0; b < 2; ++b)
#pragma unroll
            for (int m = 0; m < 4; ++m)
#pragma unroll
                for (int n = 0; n < 2; ++n) acc[a][b][m][n] = (f32x4){0.f, 0.f, 0.f, 0.f};
    bf16x8 At[4][2], B0[2][2], B1[2][2];
    const char* cA = cur.a; const char* cB = cur.b;
    PG8_STAGE(PG8_SB(0, 0), cB, voffB); PG8_STAGE(PG8_SA(0, 0), cA, voffA); PG8_STAGE(PG8_SB(0, 1), cB + hsB, voffB); PG8_STAGE(PG8_SA(0, 1), cA + hsA, voffA);
    if (wr == 1) PG8_BAR;
    PG8_WAIT_V(4); PG8_BAR;
    PG8_STAGE(PG8_SB(1, 0), cB + kstep, voffB); PG8_STAGE(PG8_SA(1, 0), cA + kstep, voffA); PG8_STAGE(PG8_SB(1, 1), cB + hsB + kstep, voffB);
    PG8_WAIT_V(6); PG8_BAR;
    for (;;) {
        const bool has_next = S.next(ui + 1, nxt);
        const char* nA = has_next ? nxt.a : cA; const char* nB = has_next ? nxt.b : cB;
        for (int t = 0; t < nt; t += 2) {
            const bool last = (t == nt - 2);
            const char* a1 = cA + (size_t)(t + 1) * kstep;
            const char* a2 = last ? nA : cA + (size_t)(t + 2) * kstep; const char* b2 = last ? nB : cB + (size_t)(t + 2) * kstep;
            const char* a3 = a2 + kstep; const char* b3 = b2 + kstep;
            PG8_LDB(B0, 0, 0); PG8_SCHED; PG8_LDA(At, 0, 0); PG8_STAGE(PG8_SA(1, 1), a1 + hsA, voffA);
            PG8_WAIT_L(8); PG8_BAR; PG8_WAIT_L(0); PG8_MMA(0, 0, At, B0); PG8_BAR; PG8_SCHED;
            PG8_LDB(B1, 0, 1); PG8_STAGE(PG8_SB(0, 0), b2, voffB);
            PG8_BAR; PG8_WAIT_L(0); PG8_MMA(0, 1, At, B1); PG8_BAR;
            PG8_LDA(At, 0, 1); PG8_STAGE(PG8_SA(0, 0), a2, voffA);
            PG8_BAR; PG8_WAIT_L(0); PG8_MMA(1, 0, At, B0); PG8_BAR; PG8_SCHED;
            PG8_STAGE(PG8_SB(0, 1), b2 + hsB, voffB);
            PG8_WAIT_V(6); PG8_BAR; PG8_MMA(1, 1, At, B1); PG8_BAR;
            PG8_LDB(B0, 1, 0); PG8_SCHED; PG8_LDA(At, 1, 0); PG8_STAGE(PG8_SA(0, 1), a2 + hsA, voffA);
            PG8_WAIT_L(8); PG8_BAR; PG8_WAIT_L(0); PG8_MMA(0, 0, At, B0); PG8_BAR; PG8_SCHED;
            PG8_LDB(B1, 1, 1); PG8_STAGE(PG8_SB(1, 0), b3, voffB);
            PG8_BAR; PG8_WAIT_L(0); PG8_MMA(0, 1, At, B1); PG8_BAR;
            PG8_LDA(At, 1, 1); PG8_STAGE(PG8_SA(1, 0), a3, voffA);
            PG8_BAR; PG8_WAIT_L(0); PG8_MMA(1, 0, At, B0); PG8_BAR; PG8_SCHED;
            PG8_STAGE(PG8_SB(1, 1), b3 + hsB, voffB);
            PG8_WAIT_V(6); PG8_BAR; PG8_MMA(1, 1, At, B1); PG8_BAR;
        }
        E(acc, cur, wr, wc, fr, fq);
        if (!has_next) break;
#pragma unroll
        for (int a = 0; a < 2; ++a)
#pragma unroll
            for (int b = 0; b < 2; ++b)
#pragma unroll
                for (int m = 0; m < 4; ++m)
#pragma unroll
                    for (int n = 0; n < 2; ++n) acc[a][b][m][n] = (f32x4){0.f, 0.f, 0.f, 0.f};
        cur = nxt; cA = nA; cB = nB; ++ui;
    }
    PG8_WAIT_V(0);
    if (wr == 0) PG8_BAR;
    PG8_BAR;
#undef PG8_SA
#undef PG8_SB
#undef PG8_STAGE
#undef PG8_LDA
#undef PG8_LDB
#undef PG8_MMA
#undef PG8_WAIT_V
#undef PG8_WAIT_L
#undef PG8_BAR
#undef PG8_SCHED
}
}

using pg8::Unit; using pg8::BOrder;
struct TileDst { bf16_t* p; int ld; int ncols; const bf16_t* gate; int gld; int cmode, cpar, rmode, rpar; };
template <class F, bool GATE> struct EpiB {
    static constexpr bool PERM = true; F f;
    __device__ __forceinline__ void operator()(const f32x4 (&acc)[2][2][4][2], const Unit& u, int wr, int wc, int fr, int fq) const {
        const TileDst d = f(u);
        const int r0 = wr * 64 + fr, c0 = wc * 32 + 8 * fq;
#pragma unroll
        for (int ai = 0; ai < 2; ++ai)
#pragma unroll
            for (int m = 0; m < 4; ++m) { const int row = r0 + ai * 128 + m * 16; const int drow = d.rmode ? ((row & 63) * 64 + d.rpar + (row >> 6)) : row;
#pragma unroll
                for (int bj = 0; bj < 2; ++bj) { const int col = c0 + bj * 128; int dcol = col;
                    if (d.cmode == 1) dcol = (col >> 6) * 128 + (col & 63); else if (d.cmode == 2) { const int nn = d.cpar + col; dcol = (nn >> 4) * 128 + ((nn >> 3) & 1) * 64; }
                    if (col < d.ncols) {
                        f32x4 v0 = acc[ai][bj][m][0], v1 = acc[ai][bj][m][1];
                        if (GATE) { const u32x4 g = *(const u32x4*)(d.gate + (size_t)row * d.gld + col);
                            v0[0] *= silu_f(bflo(g.x)); v0[1] *= silu_f(bfhi(g.x)); v0[2] *= silu_f(bflo(g.y)); v0[3] *= silu_f(bfhi(g.y));
                            v1[0] *= silu_f(bflo(g.z)); v1[1] *= silu_f(bfhi(g.z)); v1[2] *= silu_f(bflo(g.w)); v1[3] *= silu_f(bfhi(g.w)); }
                        u32x4 w; w.x = cvt_pk_bf16(v0[0], v0[1]); w.y = cvt_pk_bf16(v0[2], v0[3]); w.z = cvt_pk_bf16(v1[0], v1[1]); w.w = cvt_pk_bf16(v1[2], v1[3]);
                        *(u32x4*)(d.p + (size_t)drow * d.ld + dcol) = w; } } }
    }
};
struct DstInProj { unsigned char* ws;
    __device__ __forceinline__ TileDst operator()(const Unit& u) const { const int pn = u.pn; size_t off; int ld, co, nc = 256;
        if (pn < 8) { off = WS_FIN; ld = 2048; co = pn * 256; } else if (pn < 16) { off = WS_FGATE; ld = 2048; co = (pn - 8) * 256; }
        else if (pn < 20) { off = WS_Q; ld = 1024; co = (pn - 16) * 256; } else if (pn < 24) { off = WS_K; ld = 1024; co = (pn - 20) * 256; }
        else if (pn < 32) { off = WS_V; ld = 2048; co = (pn - 24) * 256; } else if (pn < 40) { off = WS_GG; ld = 2048; co = (pn - 32) * 256; }
        else { off = WS_AB; ld = 32; co = 0; nc = 32; }
        TileDst d; d.cmode = 0; d.cpar = 0; d.rmode = 0; d.rpar = 0; d.p = (bf16_t*)(ws + off) + (size_t)u.pm * 256 * ld + co; d.ld = ld; d.ncols = nc; d.gate = nullptr; d.gld = 0; return d; } };
struct DstChDft { unsigned char* ws;
    __device__ __forceinline__ TileDst operator()(const Unit& u) const { const int g = u.bz, part = u.pm >> 1, cp0 = (u.pm & 1) * 256, pn = u.pn; TileDst d; d.cmode = 0; d.cpar = 0; d.rmode = 0; d.rpar = 0; d.ncols = 256; d.gate = nullptr; d.gld = 0;
        if (pn < 32) { d.ld = 16384; d.p = (bf16_t*)(ws + WS_ZTC) + (size_t)(g * 512 + cp0) * 16384 + pn * 512 + part * 256; }
        else { const int lt = (pn - 32) * 256, b = lt >> 12, l0 = lt & 4095; d.ld = 65536; d.cmode = 1; d.p = (bf16_t*)(ws + WS_ZTL) + (size_t)(g * 512 + cp0) * 65536 + b * 8192 + (l0 >> 6) * 128 + part * 64; }
        return d; } };
struct DstPosCtx { unsigned char* ws;
    __device__ __forceinline__ TileDst operator()(const Unit& u) const { const int b = u.bz >> 2, g = u.bz & 3; TileDst d; d.cmode = 0; d.cpar = 0; d.rmode = 0; d.rpar = 0; d.ncols = 256; d.gate = nullptr; d.gld = 0; d.ld = 2048;
        d.p = (bf16_t*)(ws + WS_RE) + (size_t)(b * 256) * 2048 + g * 512 + u.pn * 256; return d; } };
struct DstLatA { unsigned char* ws;
    __device__ __forceinline__ TileDst operator()(const Unit& u) const { TileDst d; d.cmode = 2; d.cpar = (u.pn & 3) * 256; d.rmode = 0; d.rpar = 0; d.ncols = 256; d.gate = nullptr; d.gld = 0; d.ld = 8192;
        d.p = (bf16_t*)(ws + WS_OF) + (size_t)(u.pm * 256) * 8192 + (u.pn >> 2) * 8; return d; } };
struct DstLatB { unsigned char* ws;
    __device__ __forceinline__ TileDst operator()(const Unit& u) const { const int b = u.bz >> 2, g = u.bz & 3; TileDst d; d.cmode = 0; d.cpar = 0; d.rmode = 1; d.rpar = u.pm * 4; d.ncols = 256; d.gate = nullptr; d.gld = 0; d.ld = 2048;
        d.p = (bf16_t*)(ws + WS_RE) + (size_t)(TC + b * 4096) * 2048 + g * 512 + u.pn * 256; return d; } };
struct DstWf { unsigned char* ws;
    __device__ __forceinline__ TileDst operator()(const Unit& u) const { const int g = u.bz; TileDst d; d.cmode = 0; d.cpar = 0; d.rmode = 0; d.rpar = 0; d.ncols = 256; d.ld = 4096; d.gld = 2048;
        d.p = (bf16_t*)(ws + WS_MIX) + (size_t)(u.pm * 256) * 4096 + g * 512 + u.pn * 256;
        d.gate = (const bf16_t*)(ws + WS_FGATE) + (size_t)(u.pm * 256) * 2048 + g * 512 + u.pn * 256; return d; } };
struct DstOut { unsigned char* ws;
    __device__ __forceinline__ TileDst operator()(const Unit& u) const { TileDst d; d.cmode = 0; d.cpar = 0; d.rmode = 0; d.rpar = 0; d.ncols = 256; d.gate = nullptr; d.gld = 0; d.ld = 4096;
        d.p = (bf16_t*)(ws + WS_OF) + (size_t)(u.pm * 256) * 4096 + u.pn * 256; return d; } };
struct EpiOut {
    static constexpr bool PERM = false; const float* xp; const float* xs; const float* modv; float* out;
    __device__ __forceinline__ void operator()(const f32x4 (&acc)[2][2][4][2], const Unit& u, int wr, int wc, int fr, int fq) const {
        const int t0 = u.pm * 256; const int bidx = t0 < TC ? 0 : 1 + ((t0 - TC) >> 12);
        const float* x = (t0 < TC ? xp + (size_t)t0 * 4096 : xs + (size_t)(t0 - TC) * 4096) + u.pn * 256;
        const float* gt = modv + bidx * 12288 + 8192 + u.pn * 256; float* o = out + (size_t)t0 * 4096 + u.pn * 256;
        const int r0 = wr * 64 + fr, c0 = wc * 32 + 4 * fq;
#pragma unroll
        for (int ai = 0; ai < 2; ++ai)
#pragma unroll
            for (int m = 0; m < 4; ++m) { const size_t ro = (size_t)(r0 + ai * 128 + m * 16) * 4096;
#pragma unroll
                for (int bj = 0; bj < 2; ++bj)
#pragma unroll
                    for (int n = 0; n < 2; ++n) { const int col = c0 + bj * 128 + n * 16; const f32x4 g = *(const f32x4*)(gt + col); const f32x4 xv = *(const f32x4*)(x + ro + col);
                        *(f32x4*)(o + ro + col) = xv + g * acc[ai][bj][m][n]; } }
    }
};

__device__ __forceinline__ void store_bf8(bf16_t* p, const float (&e)[8]) { u32x4 w; w.x = cvt_pk_bf16(e[0], e[1]); w.y = cvt_pk_bf16(e[2], e[3]); w.z = cvt_pk_bf16(e[4], e[5]); w.w = cvt_pk_bf16(e[6], e[7]); *(u32x4*)p = w; }
__device__ __forceinline__ void phase0(const Args& a, LAS unsigned char* lds, const int G, const int c) {
    const int tid = fresh_tid(), wid = tid >> 6, lane = tid & 63;
    float* modv = (float*)(a.ws + WS_MODV);
    {   LAS float* sv = (LAS float*)(lds + wid * 4608);
        for (int task = c * 8 + wid; task < 1536; task += G * 8) {
            const int cb = task % 48, ks = task / 48, k0 = ks * 128;
            for (int e = lane; e < 9 * 128; e += 64) { const int bi = e >> 7, kk = e & 127; const float x = bi == 0 ? a.c_ctx[k0 + kk] : a.c[(bi - 1) * 4096 + k0 + kk]; sv[e] = silu_f(x); }
            f32x4 acc[9];
#pragma unroll
            for (int bi = 0; bi < 9; ++bi) acc[bi] = (f32x4){0.f, 0.f, 0.f, 0.f};
            const float* wp = a.ada_w + (size_t)k0 * 12288 + cb * 256 + lane * 4;
#pragma unroll 4
            for (int kk = 0; kk < 128; ++kk) { const f32x4 w = *(const f32x4*)(wp + (size_t)kk * 12288);
#pragma unroll
                for (int bi = 0; bi < 9; ++bi) acc[bi] += sv[bi * 128 + kk] * w; }
            const int col = cb * 256 + lane * 4;
#pragma unroll
            for (int bi = 0; bi < 9; ++bi)
#pragma unroll
                for (int e = 0; e < 4; ++e) { const float v = acc[bi][e] + (ks == 0 ? a.ada_b[col + e] : 0.f); atomicAdd(modv + bi * 12288 + col + e, v); }
        }
    }
    __syncthreads();
    {   LAS float* tile = (LAS float*)(lds + 40960);
        for (int tt = c; tt < 2624 + 1024 + 64; tt += G) {
            const float* src; bf16_t* dst; int N, Kd, kt, ng;
            if (tt < 2624) { kt = tt / 41; ng = tt % 41; src = a.w_in; N = NIN; Kd = 4096; dst = (bf16_t*)(a.ws + WS_WINT); }
            else if (tt < 3648) { const int t2 = tt - 2624; kt = t2 >> 4; ng = t2 & 15; src = a.w_out; N = 4096; Kd = 4096; dst = (bf16_t*)(a.ws + WS_WOUTT); }
            else { const int t2 = tt - 3648, g = t2 >> 4, r = t2 & 15; kt = r >> 1; ng = r & 1; src = a.w_fourier + (size_t)g * 512 * 512; N = 512; Kd = 512; dst = (bf16_t*)(a.ws + WS_WFT) + (size_t)g * 512 * 512; }
            const int k0 = kt * 64, n0 = ng * 256;
            {   const int r = tid >> 4, c4 = (tid & 15) * 4; f32x4 v[4][2];
#pragma unroll
                for (int sub = 0; sub < 4; ++sub)
#pragma unroll
                    for (int rr = 0; rr < 2; ++rr) { v[sub][rr] = (f32x4){0.f, 0.f, 0.f, 0.f}; if (n0 + sub * 64 + c4 < N) v[sub][rr] = *(const f32x4*)(src + (size_t)(k0 + r + rr * 32) * N + n0 + sub * 64 + c4); }
#pragma unroll
                for (int sub = 0; sub < 4; ++sub)
#pragma unroll
                    for (int rr = 0; rr < 2; ++rr) { LAS float* tp = tile + sub * 4160 + (r + rr * 32) * 65 + c4; tp[0] = v[sub][rr][0]; tp[1] = v[sub][rr][1]; tp[2] = v[sub][rr][2]; tp[3] = v[sub][rr][3]; } }
            __syncthreads();
            {   const int n = tid >> 3, kq = (tid & 7) * 8;
#pragma unroll
                for (int sub = 0; sub < 4; ++sub) { float e[8];
#pragma unroll
                    for (int i = 0; i < 8; ++i) e[i] = tile[sub * 4160 + (kq + i) * 65 + n];
                    store_bf8(dst + (size_t)(n0 + sub * 64 + n) * Kd + k0 + kq, e); } }
            __syncthreads();
        }
    }
    {   const size_t nth = (size_t)G * 512, gt = (size_t)c * 512 + tid;
        bf16_t* dch = (bf16_t*)(a.ws + WS_DCH); bf16_t* pctx = (bf16_t*)(a.ws + WS_PCTX); bf16_t* plat = (bf16_t*)(a.ws + WS_PLAT);
        for (size_t e = gt; e < 65536; e += nth) { const int r = (int)(e >> 6), c0 = (int)(e & 63) * 8, rr = r & 511; const bool sn = r >= 512; float v[8];
#pragma unroll
            for (int i = 0; i < 8; ++i) { const int p = (rr * (c0 + i)) & 511; const float ang = (float)p * (2.0f / 512.0f); v[i] = (sn ? sinpif(ang) : cospif(ang)) * 0.044194173824159216f; }
            store_bf8(dch + e * 8, v); }
        for (size_t e = gt; e < 16384; e += nth) { const int r = (int)(e >> 6), k0 = (int)(e & 63) * 8; const bool sn = k0 >= 256; float v[8];
#pragma unroll
            for (int i = 0; i < 8; ++i) { const int p = (r * ((k0 + i) & 255)) & 255; const float ang = (float)p * (2.0f / 256.0f); v[i] = (sn ? -sinpif(ang) : cospif(ang)) * 0.0625f; }
            store_bf8(pctx + e * 8, v); }
        bf16_t* ba = plat; bf16_t* ab = plat + (size_t)1024 * 1024;
        for (size_t e = gt; e < 131072; e += nth) { const int nn = (int)(e >> 7), k0 = (int)(e & 127) * 8; const int c2p = nn >> 4, comp = (nn >> 3) & 1, rl = nn & 7; float v[8];
#pragma unroll
            for (int i = 0; i < 8; ++i) { const int kk = k0 + i, rl2 = kk >> 7, part = (kk >> 6) & 1, c2 = kk & 63; const float ang = (float)((c2 * c2p) & 63) * (2.0f / 64.0f); const float cs = cospif(ang), sn = sinpif(ang);
                const float f = comp == 0 ? (part == 0 ? cs : -sn) : (part == 0 ? sn : cs); v[i] = rl == rl2 ? f * 0.125f : 0.f; }
            store_bf8(ba + e * 8, v); }
        for (size_t e = gt; e < 16384; e += nth) { const int ii = (int)(e >> 6), k0 = (int)(e & 63) * 8; const int c2l = ii >> 6, rp = ii & 63; float v[8];
#pragma unroll
            for (int i = 0; i < 8; ++i) { const int kk = k0 + i, c2l2 = kk >> 7, comp = (kk >> 6) & 1, r = kk & 63; const float ang = (float)((r * rp) & 63) * (2.0f / 64.0f);
                const float f = comp == 0 ? cospif(ang) : -sinpif(ang); v[i] = c2l == c2l2 ? f * 0.125f : 0.f; }
            store_bf8(ab + e * 8, v); }
    }
}

__device__ __forceinline__ void phase_h(const Args& a, const int G, const int c) {
    const int tid = fresh_tid(), wid = tid >> 6, lane = tid & 63;
    const float* modv = (const float*)(a.ws + WS_MODV); bf16_t* H = (bf16_t*)(a.ws + WS_H);
    for (int t = c * 8 + wid; t < T; t += G * 8) {
        const float* x = t < TC ? a.x_prompt + (size_t)t * 4096 : a.x_sample + (size_t)(t - TC) * 4096;
        const int bidx = t < TC ? 0 : 1 + ((t - TC) >> 12); const float* mv = modv + bidx * 12288;
        f32x4 v[16]; float ss = 0.f;
#pragma unroll
        for (int it = 0; it < 16; ++it) { v[it] = *(const f32x4*)(x + it * 256 + lane * 4); ss += v[it][0] * v[it][0] + v[it][1] * v[it][1] + v[it][2] * v[it][2] + v[it][3] * v[it][3]; }
        ss = wave_sum(ss); const float rstd = rsqrtf(ss * (1.0f / 4096.0f) + 1e-6f);
#pragma unroll
        for (int it = 0; it < 16; ++it) { const int col = it * 256 + lane * 4; const f32x4 nw = *(const f32x4*)(a.norm_w + col), sh = *(const f32x4*)(mv + col), sc = *(const f32x4*)(mv + 4096 + col);
            const f32x4 hv = v[it] * rstd * nw * (1.0f + sc) + sh; u32x2 w; w.x = cvt_pk_bf16(hv[0], hv[1]); w.y = cvt_pk_bf16(hv[2], hv[3]); *(u32x2*)(H + (size_t)t * 4096 + col) = w; }
    }
}
__device__ __forceinline__ void phase_glapost(const Args& a, const int G, const int c) {
    const int tid = fresh_tid(), wid = tid >> 6, lane = tid & 63;
    const bf16_t* OF = (const bf16_t*)(a.ws + WS_OF); const bf16_t* OB = (const bf16_t*)(a.ws + WS_OB); const bf16_t* GG = (const bf16_t*)(a.ws + WS_GG); bf16_t* MIX = (bf16_t*)(a.ws + WS_MIX);
    for (int task = c * 8 + wid; task < T * 4; task += G * 8) { const int t = task >> 2, h = task & 3, col = h * 512 + lane * 8;
        const u32x4 f = *(const u32x4*)(OF + (size_t)t * 2048 + col), b = *(const u32x4*)(OB + (size_t)t * 2048 + col), g = *(const u32x4*)(GG + (size_t)t * 2048 + col);
        float o[8]; o[0] = bflo(f.x) + bflo(b.x); o[1] = bfhi(f.x) + bfhi(b.x); o[2] = bflo(f.y) + bflo(b.y); o[3] = bfhi(f.y) + bfhi(b.y); o[4] = bflo(f.z) + bflo(b.z); o[5] = bfhi(f.z) + bfhi(b.z); o[6] = bflo(f.w) + bflo(b.w); o[7] = bfhi(f.w) + bfhi(b.w);
        float gg[8]; gg[0] = bflo(g.x); gg[1] = bfhi(g.x); gg[2] = bflo(g.y); gg[3] = bfhi(g.y); gg[4] = bflo(g.z); gg[5] = bfhi(g.z); gg[6] = bflo(g.w); gg[7] = bfhi(g.w);
        float ss = 0.f;
#pragma unroll
        for (int i = 0; i < 8; ++i) ss += o[i] * o[i];
        ss = wave_sum(ss); const float rstd = rsqrtf(ss * (1.0f / 512.0f) + 1e-6f);
        const f32x4 w0 = *(const f32x4*)(a.gla_norm_w + col), w1 = *(const f32x4*)(a.gla_norm_w + col + 4); float e[8];
#pragma unroll
        for (int i = 0; i < 8; ++i) e[i] = o[i] * rstd * (i < 4 ? w0[i & 3] : w1[i & 3]) * silu_f(gg[i]);
        store_bf8(MIX + (size_t)t * 4096 + 2048 + col, e); }
}
__device__ __forceinline__ void phase_final(const Args& a, const int G, const int c) {
    const int tid = fresh_tid(), wid = tid >> 6, lane = tid & 63;
    const float* modv = (const float*)(a.ws + WS_MODV); const bf16_t* OUTB = (const bf16_t*)(a.ws + WS_OF);
    for (int t = c * 8 + wid; t < T; t += G * 8) {
        const float* x = t < TC ? a.x_prompt + (size_t)t * 4096 : a.x_sample + (size_t)(t - TC) * 4096;
        const int bidx = t < TC ? 0 : 1 + ((t - TC) >> 12); const float* gt = modv + bidx * 12288 + 8192; float* y = a.out + (size_t)t * 4096;
        f32x4 v[16]; float ss = 0.f;
#pragma unroll
        for (int it = 0; it < 16; ++it) { const int col = it * 256 + lane * 4; const f32x4 xv = *(const f32x4*)(x + col); const f32x4 g = *(const f32x4*)(gt + col); const u32x2 ob = *(const u32x2*)(OUTB + (size_t)t * 4096 + col);
            v[it] = xv + g * (f32x4){bflo(ob.x), bfhi(ob.x), bflo(ob.y), bfhi(ob.y)}; ss += v[it][0] * v[it][0] + v[it][1] * v[it][1] + v[it][2] * v[it][2] + v[it][3] * v[it][3]; }
        ss = wave_sum(ss); const float rstd = rsqrtf(ss * (1.0f / 4096.0f) + 1e-6f);
#pragma unroll
        for (int it = 0; it < 16; ++it) { const int col = it * 256 + lane * 4; const f32x4 nw = *(const f32x4*)(a.final_norm_w + col); *(f32x4*)(y + col) = v[it] * rstd * nw; }
    }
}

__device__ __forceinline__ f32x4 mfma16(bf16x8 a, bf16x8 b, f32x4 c) { return __builtin_amdgcn_mfma_f32_16x16x32_bf16(a, b, c, 0, 0, 0); }
__device__ __forceinline__ unsigned short f2bf(float f) { return (unsigned short)(cvt_pk_bf16(f, 0.f) & 0xffffu); }
__device__ __forceinline__ void phase_gla_pre(const Args& a, LAS unsigned char* lds, const int G, const int c) {
    constexpr int QS = 264;
    LAS bf16_t* QT = (LAS bf16_t*)(lds);
    LAS bf16_t* KT = (LAS bf16_t*)(lds + 33792);
    LAS bf16_t* KD = (LAS bf16_t*)(lds + 67584);
    LAS float* TOT = (LAS float*)(lds + 129024);
    LAS float* AL = (LAS float*)(lds + 131072);
    const int tid = fresh_tid(), k = tid & 255, half = __builtin_amdgcn_readfirstlane(tid >> 8);
    const bf16_t* Qb = (const bf16_t*)(a.ws + WS_Q); const bf16_t* Kb = (const bf16_t*)(a.ws + WS_K); const bf16_t* ABb = (const bf16_t*)(a.ws + WS_AB);
    for (int task = c; task < 5120; task += G) {
        int chunk, s, L, base;
        if (task < 4096) { chunk = task & 63; s = task >> 6; L = 4096; base = TC + (s >> 3) * 4096; } else { const int t2 = task - 4096; chunk = t2 & 3; s = t2 >> 2; L = 256; base = (s >> 3) * 256; }
        const int dir = s & 1, h = (s >> 1) & 3, c0 = chunk * 64;
#define TOKC(cj) (base + (dir ? (L - 1 - (cj)) : (cj)))
        float wv[16];
#pragma unroll
        for (int r = 0; r < 16; ++r) wv[r] = a.w_alpha[(dir * 16 + r) * 1024 + h * 256 + k];
        const float bias = a.b_alpha[dir * 1024 + h * 256 + k];
#pragma unroll
        for (int i = 0; i < 4; ++i) { const int id = tid + 512 * i, j = id >> 5, ch = id & 31; const size_t ro = (size_t)TOKC(c0 + j) * 1024 + h * 256 + ch * 8;
            *(LAS u32x4*)(QT + j * QS + ch * 8) = *(const u32x4*)(Qb + ro); *(LAS u32x4*)(KT + j * QS + ch * 8) = *(const u32x4*)(Kb + ro); }
        if (tid < 128) { const int j = tid >> 1, ch = tid & 1; const u32x4 pa = *(const u32x4*)(ABb + (size_t)TOKC(c0 + j) * 32 + dir * 16 + ch * 8); LAS float* ap = AL + j * 16 + ch * 8;
            *(LAS f32x4*)ap = (f32x4){bflo(pa.x), bfhi(pa.x), bflo(pa.y), bfhi(pa.y)}; *(LAS f32x4*)(ap + 4) = (f32x4){bflo(pa.z), bfhi(pa.z), bflo(pa.w), bfhi(pa.w)}; }
#undef TOKC
        __syncthreads();
        float bc[32]; float cum = 0.f;
#pragma unroll
        for (int jj = 0; jj < 32; ++jj) { const int j = half * 32 + jj;
            const f32x4 a0 = *(const LAS f32x4*)(AL + j * 16), a1 = *(const LAS f32x4*)(AL + j * 16 + 4), a2 = *(const LAS f32x4*)(AL + j * 16 + 8), a3 = *(const LAS f32x4*)(AL + j * 16 + 12);
            float pre = bias;
#pragma unroll
            for (int r = 0; r < 4; ++r) pre += a0[r] * wv[r] + a1[r] * wv[4 + r] + a2[r] * wv[8 + r] + a3[r] * wv[12 + r];
            const float ls = fminf(pre, 0.f) - __logf(1.0f + __expf(-fabsf(pre)));
            cum += ls * 0.0625f; bc[jj] = cum; }
        TOT[half * 256 + k] = cum;
        __syncthreads();
        const float t0 = TOT[k], t1 = TOT[256 + k]; const float off = half ? t0 : 0.f; const float bl = t0 + t1;
        if (half == 0) ((float*)(a.ws + WS_DECG))[((size_t)dir * (T / 64) + ((base + c0) >> 6)) * 1024 + h * 256 + k] = __expf(bl);
#pragma unroll
        for (int jj = 0; jj < 32; ++jj) { const int j = half * 32 + jj; const float qv = bf2f(QT[j * QS + k]), kv = bf2f(KT[j * QS + k]); const float bb = bc[jj] + off;
            QT[j * QS + k] = f2bf(qv * __expf(bb) * 0.0625f); KT[j * QS + k] = f2bf(kv * __expf(-bb)); KD[j * QS + k] = f2bf(kv * __expf(bl - bb)); }
        __syncthreads();
        {   bf16_t* qg = (bf16_t*)(a.ws + WS_QTG) + (size_t)dir * T * 1024; bf16_t* kg = (bf16_t*)(a.ws + WS_KTG) + (size_t)dir * T * 1024; bf16_t* dg = (bf16_t*)(a.ws + WS_KDG) + (size_t)dir * T * 1024;
#pragma unroll
            for (int i = 0; i < 4; ++i) { const int id = tid + 512 * i, j = id >> 5, ch = id & 31; const size_t ro = (size_t)(base + c0 + j) * 1024 + h * 256 + ch * 8;
                *(u32x4*)(qg + ro) = *(const LAS u32x4*)(QT + j * QS + ch * 8); *(u32x4*)(kg + ro) = *(const LAS u32x4*)(KT + j * QS + ch * 8); *(u32x4*)(dg + ro) = *(const LAS u32x4*)(KD + j * QS + ch * 8); } }
        __syncthreads();
    }
}
typedef short s16x4 __attribute__((ext_vector_type(4)));
__device__ __forceinline__ bf16x8 tr_read8(const LAS bf16_t* p0, const int stride_el) {
    const s16x4 lo = __builtin_amdgcn_ds_read_tr16_b64_v4i16((LAS s16x4*)p0), hi = __builtin_amdgcn_ds_read_tr16_b64_v4i16((LAS s16x4*)(p0 + 4 * stride_el));
    return __builtin_shufflevector(lo, hi, 0, 1, 2, 3, 4, 5, 6, 7); }
__device__ __forceinline__ void phase_gla(const Args& a, LAS unsigned char* lds, const int G, const int c) {
    constexpr int QS = 264, VS = 136, KS = 72;
    LAS bf16_t* QT = (LAS bf16_t*)(lds);
    LAS bf16_t* KT = (LAS bf16_t*)(lds + 33792);
    LAS bf16_t* KD = (LAS bf16_t*)(lds + 67584);
    LAS bf16_t* VR = (LAS bf16_t*)(lds + 101376);
    LAS bf16_t* ATT = (LAS bf16_t*)(lds + 118784);
    LAS float* DEC = (LAS float*)(lds + 128000);
    const int tid = fresh_tid(), w = __builtin_amdgcn_readfirstlane(tid >> 6), lane = tid & 63, n = lane & 15, q = lane >> 4;
    const int trq = (lane & 15) >> 2, trp = lane & 3;
    const bf16_t* Vb = (const bf16_t*)(a.ws + WS_V);
    for (int u = c; u < 256 + 1024; u += G) {
        const bool lat = u < 256; const int uu = lat ? u : u - 256;
        const int sl = (uu & 7) * 8 + (((uu & 255) >> 3) >> 2), vs = ((uu & 255) >> 3) & 3, s = (uu >> 8) * 64 + sl;
        const int dir = s & 1, h = (s >> 1) & 3, b = s >> 3;
        const int L = lat ? 4096 : 256, base = lat ? TC + b * 4096 : b * 256, nsteps = L >> 6;
        f32x4 S[16];
        if (lat) { const float* sp = (dir ? a.st_b : a.st_f) + ((size_t)(b * 4 + h) * 256) * 512 + vs * 128 + w * 16 + n;
#pragma unroll
            for (int t = 0; t < 16; ++t)
#pragma unroll
                for (int r = 0; r < 4; ++r) S[t][r] = sp[(size_t)(t * 16 + 4 * q + r) * 512]; }
        else {
#pragma unroll
            for (int t = 0; t < 16; ++t) S[t] = (f32x4){0.f, 0.f, 0.f, 0.f}; }
        bf16_t* OX = (bf16_t*)(a.ws + (dir ? WS_OB : WS_OF));
        const bf16_t* qg = (const bf16_t*)(a.ws + WS_QTG) + (size_t)dir * T * 1024 + h * 256; const bf16_t* kg = (const bf16_t*)(a.ws + WS_KTG) + (size_t)dir * T * 1024 + h * 256; const bf16_t* dg = (const bf16_t*)(a.ws + WS_KDG) + (size_t)dir * T * 1024 + h * 256;
        const float* decg = (const float*)(a.ws + WS_DECG) + (size_t)dir * (T / 64) * 1024 + h * 256;
#define TOKC(cj) (base + (dir ? (L - 1 - (cj)) : (cj)))
        u32x4 pq[4], pk[4], pd[4], pv[2], pe;
#define GLA_LOAD(stp) do { const int cc0 = (stp) * 64; \
            _Pragma("unroll") for (int i = 0; i < 4; ++i) { const int id = tid + 512 * i, j = id >> 5, ch = id & 31; const size_t ro = (size_t)(base + cc0 + j) * 1024 + ch * 8; pq[i] = *(const u32x4*)(qg + ro); pk[i] = *(const u32x4*)(kg + ro); pd[i] = *(const u32x4*)(dg + ro); } \
            _Pragma("unroll") for (int i = 0; i < 2; ++i) { const int id = tid + 512 * i, j = id >> 4, ch = id & 15; pv[i] = *(const u32x4*)(Vb + (size_t)TOKC(cc0 + j) * 2048 + h * 512 + vs * 128 + ch * 8); } \
            if (tid < 64) pe = *(const u32x4*)(decg + (size_t)((base + cc0) >> 6) * 1024 + tid * 4); } while (0)
        pe = (u32x4){0u, 0u, 0u, 0u};
        GLA_LOAD(0);
        for (int step = 0; step < nsteps; ++step) {
            const int c0 = step * 64;
#pragma unroll
            for (int i = 0; i < 4; ++i) { const int id = tid + 512 * i, j = id >> 5, ch = id & 31; *(LAS u32x4*)(QT + j * QS + ch * 8) = pq[i]; *(LAS u32x4*)(KT + j * QS + ch * 8) = pk[i]; *(LAS u32x4*)(KD + j * QS + ch * 8) = pd[i]; }
#pragma unroll
            for (int i = 0; i < 2; ++i) { const int id = tid + 512 * i, j = id >> 4, ch = id & 15; *(LAS u32x4*)(VR + j * VS + ch * 8) = pv[i]; }
            if (tid < 64) *(LAS u32x4*)(DEC + tid * 4) = pe;
            { const int ns = step + 1 < nsteps ? step + 1 : step; GLA_LOAD(ns); }
            __syncthreads();
#pragma unroll
            for (int tt = 0; tt < 2; ++tt) { const int id = w * 2 + tt, jt = id >> 2, it = id & 3; f32x4 acc = (f32x4){0.f, 0.f, 0.f, 0.f};
                if (jt <= it) {
#pragma unroll
                    for (int ks = 0; ks < 8; ++ks) { const bf16x8 A = *(const LAS bf16x8*)(KT + (jt * 16 + n) * QS + ks * 32 + 8 * q); const bf16x8 B = *(const LAS bf16x8*)(QT + (it * 16 + n) * QS + ks * 32 + 8 * q); acc = mfma16(A, B, acc); }
#pragma unroll
                    for (int r = 0; r < 4; ++r) if (jt * 16 + 4 * q + r > it * 16 + n) acc[r] = 0.f; }
                u32x2 pk2; pk2.x = cvt_pk_bf16(acc[0], acc[1]); pk2.y = cvt_pk_bf16(acc[2], acc[3]);
                *(LAS u32x2*)(ATT + (it * 16 + n) * KS + jt * 16 + 4 * q) = pk2; }
            f32x4 o[4];
#pragma unroll
            for (int mt = 0; mt < 4; ++mt) o[mt] = (f32x4){0.f, 0.f, 0.f, 0.f};
#pragma unroll
            for (int kb = 0; kb < 8; ++kb) { u32x4 bs; bs.x = cvt_pk_bf16(S[2 * kb][0], S[2 * kb][1]); bs.y = cvt_pk_bf16(S[2 * kb][2], S[2 * kb][3]); bs.z = cvt_pk_bf16(S[2 * kb + 1][0], S[2 * kb + 1][1]); bs.w = cvt_pk_bf16(S[2 * kb + 1][2], S[2 * kb + 1][3]);
                const bf16x8 Bs = __builtin_bit_cast(bf16x8, bs);
#pragma unroll
                for (int mt = 0; mt < 4; ++mt) { const u32x2 lo = *(const LAS u32x2*)(QT + (mt * 16 + n) * QS + kb * 32 + 4 * q), hi = *(const LAS u32x2*)(QT + (mt * 16 + n) * QS + kb * 32 + 16 + 4 * q);
                    u32x4 av; av.x = lo.x; av.y = lo.y; av.z = hi.x; av.w = hi.y; o[mt] = mfma16(__builtin_bit_cast(bf16x8, av), Bs, o[mt]); } }
            __syncthreads();
            bf16x8 Bv[2];
#pragma unroll
            for (int js = 0; js < 2; ++js) Bv[js] = tr_read8(VR + (js * 32 + 8 * q + trq) * VS + w * 16 + 4 * trp, VS);
#pragma unroll
            for (int mt = 0; mt < 4; ++mt)
#pragma unroll
                for (int js = 0; js < 2; ++js) { const bf16x8 A = *(const LAS bf16x8*)(ATT + (mt * 16 + n) * KS + js * 32 + 8 * q); o[mt] = mfma16(A, Bv[js], o[mt]); }
#pragma unroll
            for (int mt = 0; mt < 4; ++mt)
#pragma unroll
                for (int r = 0; r < 4; ++r) OX[(size_t)TOKC(c0 + mt * 16 + 4 * q + r) * 2048 + h * 512 + vs * 128 + w * 16 + n] = f2bf(o[mt][r]);
#pragma unroll
            for (int t = 0; t < 16; ++t) { const f32x4 dc = *(const LAS f32x4*)(DEC + t * 16 + 4 * q); S[t] = S[t] * dc;
#pragma unroll
                for (int js = 0; js < 2; ++js) { const bf16x8 A = tr_read8(KD + (js * 32 + 8 * q + trq) * QS + t * 16 + 4 * trp, QS); S[t] = mfma16(A, Bv[js], S[t]); } }
            __syncthreads();
        }
#undef GLA_LOAD
#undef TOKC
        if (!lat) { float* sp = a.out + (size_t)167772160 + (dir ? (size_t)16777216 : (size_t)0) + ((size_t)(b * 4 + h) * 256) * 512 + vs * 128 + w * 16 + n;
#pragma unroll
            for (int t = 0; t < 16; ++t)
#pragma unroll
                for (int r = 0; r < 4; ++r) sp[(size_t)(t * 16 + 4 * q + r) * 512] = S[t][r]; }
    }
}

#ifndef PH_LO
#define PH_LO 0
#endif
#ifndef PH_HI
#define PH_HI 10
#endif
__global__ __launch_bounds__(512, 2) void mega(Args a) {
    extern __shared__ __attribute__((aligned(16))) unsigned char shm[];
    LAS unsigned char* lds = (LAS unsigned char*)shm;
    const int tid = fresh_tid(), G = gridDim.x, c = blockIdx.x;
    volatile LAS unsigned* st = (volatile LAS unsigned*)(lds + LDS_BARW);
    if (tid < 4) st[tid] = 0u;
    __syncthreads();
    XcdBarrier bar = xcd_barrier_post((unsigned*)(a.ws + WS_CTL), st);
    unsigned char* ws = a.ws;
    phase0(a, lds, G, c);
    xcd_barrier(bar);
    phase_h(a, G, c);
    xcd_barrier(bar);
    {
        BOrder S; S.nM = 160; S.nN = 41; S.nB = 1; S.nB2 = 1; S.G = G; S.c = c; S.nsplit = S.nN; S.aN = 0; S.bM = 0; S.A = (const char*)(ws + WS_H); S.B = (const char*)(ws + WS_WINT); S.sA1 = S.sA2 = S.sB1 = S.sB2 = 0; S.tA = (size_t)256 * 4096 * 2; S.tB = (size_t)256 * 4096 * 2;
        EpiB<DstInProj, false> E; E.f.ws = ws; pg8::gemm_phase(lds, 4096, 4096, 4096, S, E);
#if defined(PROBE_DUP_INPROJ)
        __syncthreads(); pg8::gemm_phase(lds, 4096, 4096, 4096, S, E);
#endif
    }
    xcd_barrier(bar);
    {
        BOrder S; S.nM = 4; S.nN = 160; S.nB = 4; S.nB2 = 1; S.G = G; S.c = c; S.nsplit = S.nN; S.aN = 0; S.bM = 0; S.A = (const char*)(ws + WS_DCH); S.B = (const char*)(ws + WS_FIN); S.sA1 = 0; S.sA2 = 0; S.sB1 = 1024; S.sB2 = 0; S.tA = (size_t)256 * 512 * 2; S.tB = (size_t)256 * 2048 * 2;
        EpiB<DstChDft, false> E; E.f.ws = ws; pg8::gemm_phase(lds, 512, 2048, 512, S, E); }
    xcd_barrier(bar);
    {
        BOrder S; S.nM = 1; S.nN = 2; S.nB = 128; S.nB2 = 4; S.G = G; S.c = c; S.nsplit = S.nN; S.aN = 0; S.bM = 0; S.A = (const char*)(ws + WS_PCTX); S.B = (const char*)(ws + WS_ZTC); S.sA1 = 0; S.sA2 = 0; S.sB1 = 1024; S.sB2 = (size_t)512 * 16384 * 2; S.tA = (size_t)256 * 512 * 2; S.tB = (size_t)256 * 16384 * 2;
        EpiB<DstPosCtx, false> E; E.f.ws = ws; pg8::gemm_phase(lds, 512, 16384, 512, S, E); }
    {
        BOrder S; S.nM = 64; S.nN = 32; S.nB = 1; S.nB2 = 1; S.G = G; S.c = c; S.nsplit = 4; S.aN = 2048; S.bM = 0; S.A = (const char*)(ws + WS_ZTL); S.B = (const char*)(ws + WS_PLAT); S.sA1 = S.sA2 = S.sB1 = S.sB2 = 0; S.tA = (size_t)256 * 8192 * 2; S.tB = (size_t)256 * 1024 * 2;
        EpiB<DstLatA, false> E; E.f.ws = ws; pg8::gemm_phase(lds, 8192, 1024, 1024, S, E); }
    xcd_barrier(bar);
    {
        BOrder S; S.nM = 16; S.nN = 2; S.nB = 32; S.nB2 = 4; S.G = G; S.c = c; S.nsplit = 2; S.aN = 0; S.bM = 1024; S.A = (const char*)(ws + WS_PLAT + (size_t)1024 * 1024 * 2); S.B = (const char*)(ws + WS_OF); S.sA1 = 0; S.sA2 = 0; S.sB1 = 16384; S.sB2 = (size_t)512 * 65536 * 2; S.tA = 0; S.tB = (size_t)256 * 65536 * 2;
        EpiB<DstLatB, false> E; E.f.ws = ws; pg8::gemm_phase(lds, 512, 65536, 512, S, E); }
    xcd_barrier(bar);
    {
        BOrder S; S.nM = 160; S.nN = 2; S.nB = 4; S.nB2 = 1; S.G = G; S.c = c; S.nsplit = S.nN; S.aN = 0; S.bM = 0; S.A = (const char*)(ws + WS_RE); S.B = (const char*)(ws + WS_WFT); S.sA1 = 1024; S.sA2 = 0; S.sB1 = (size_t)512 * 512 * 2; S.sB2 = 0; S.tA = (size_t)256 * 2048 * 2; S.tB = (size_t)256 * 512 * 2;
        EpiB<DstWf, true> E; E.f.ws = ws; pg8::gemm_phase(lds, 2048, 512, 512, S, E); }
    xcd_barrier(bar);
    phase_gla_pre(a, lds, G, c);
    xcd_barrier(bar);
    phase_gla(a, lds, G, c);
#if defined(PROBE_DUP_GLA)
    __syncthreads(); phase_gla(a, lds, G, c);
#endif
    xcd_barrier(bar);
    phase_glapost(a, G, c);
    xcd_barrier(bar);
    {
        BOrder S; S.nM = 160; S.nN = 16; S.nB = 1; S.nB2 = 1; S.G = G; S.c = c; S.nsplit = S.nN; S.aN = 0; S.bM = 0; S.A = (const char*)(ws + WS_MIX); S.B = (const char*)(ws + WS_WOUTT); S.sA1 = S.sA2 = S.sB1 = S.sB2 = 0; S.tA = (size_t)256 * 4096 * 2; S.tB = (size_t)256 * 4096 * 2;
        EpiB<DstOut, false> E; E.f.ws = ws; pg8::gemm_phase(lds, 4096, 4096, 4096, S, E); }
    xcd_barrier(bar);
    phase_final(a, G, c);
}

extern "C" void kernel_launch(void* const* d_in, const int* in_sizes, int n_in, void* d_out, int out_size, void* d_ws, size_t ws_size, hipStream_t stream) {
    static int grid = 0;
    if (grid == 0) {
        int dev = 0, cus = 0, per_cu = 0;
        if (n_in != 16 || ws_size < WS_END) { grid = -1; return; }
        if (hipGetDevice(&dev) != hipSuccess || hipDeviceGetAttribute(&cus, hipDeviceAttributeMultiprocessorCount, dev) != hipSuccess) { grid = -1; return; }
        if (hipFuncSetAttribute((const void*)mega, hipFuncAttributeMaxDynamicSharedMemorySize, LDS_BYTES) != hipSuccess) { grid = -1; return; }
        if (hipOccupancyMaxActiveBlocksPerMultiprocessor(&per_cu, (const void*)mega, 512, LDS_BYTES) != hipSuccess || per_cu < 1) { (void)hipGetLastError(); per_cu = 1; }
        grid = cus;
        if (grid > 256) grid = 256;
    }
    if (grid < 0) return;
    (void)hipMemsetAsync((char*)d_ws + WS_CTL, 0, WS_ZERO_BYTES, stream);
    Args a{};
    a.x_prompt = (const float*)d_in[0]; a.x_sample = (const float*)d_in[1]; a.st_f = (const float*)d_in[2]; a.st_b = (const float*)d_in[3]; a.c = (const float*)d_in[4]; a.c_ctx = (const float*)d_in[5];
    a.ada_w = (const float*)d_in[6]; a.ada_b = (const float*)d_in[7]; a.norm_w = (const float*)d_in[8]; a.w_in = (const float*)d_in[9]; a.w_alpha = (const float*)d_in[10]; a.b_alpha = (const float*)d_in[11];
    a.w_fourier = (const float*)d_in[12]; a.gla_norm_w = (const float*)d_in[13]; a.w_out = (const float*)d_in[14]; a.final_norm_w = (const float*)d_in[15];
    a.out = (float*)d_out; a.ws = (unsigned char*)d_ws;
    hipLaunchKernelGGL(mega, dim3(grid), dim3(512), LDS_BYTES, stream, a);
}
```

```cpp
#include <hip/hip_runtime.h>
#include <stdint.h>
#define LAS __attribute__((address_space(3)))
typedef unsigned short bf16_t;
typedef short bf16x8 __attribute__((ext_vector_type(8)));
typedef short bf16x4 __attribute__((ext_vector_type(4)));
typedef float f32x4 __attribute__((ext_vector_type(4)));
typedef float f32x2 __attribute__((ext_vector_type(2)));
typedef unsigned u32x4 __attribute__((ext_vector_type(4)));
typedef unsigned u32x2 __attribute__((ext_vector_type(2)));

constexpr int D = 4096, TC = 8192, TL = 32768, T = TC + TL, NIN = 10272, NINP = 10496;
constexpr int LDS_BYTES = 147456;
constexpr int LDS_BARW = 147456 - 16;
constexpr size_t WS_CTL = 0;
constexpr size_t WS_MODV = 16384;
constexpr size_t WS_ZERO_BYTES = 16384 + 9 * 12288 * 4;
constexpr size_t WS_H = 1u << 20;
constexpr size_t SZ_H = (size_t)T * 4096 * 2;
constexpr size_t WS_ZTC = WS_H;
constexpr size_t WS_ZTL = WS_H + (size_t)4 * 512 * 16384 * 2;
constexpr size_t WS_MIX = WS_H;
constexpr size_t WS_WINT = WS_H + SZ_H;
constexpr size_t WS_WOUTT = WS_WINT + (size_t)NINP * 4096 * 2;
constexpr size_t WS_WFT = WS_WOUTT + (size_t)4096 * 4096 * 2;
constexpr size_t WS_DCH = WS_WFT + (size_t)4 * 512 * 512 * 2;
constexpr size_t WS_PCTX = WS_DCH + (size_t)1024 * 512 * 2;
constexpr size_t WS_PLAT = WS_PCTX + (size_t)256 * 512 * 2;
constexpr size_t WS_FIN = WS_PLAT + (size_t)4096 * 8192 * 2;
constexpr size_t WS_RE = WS_FIN;
constexpr size_t WS_FGATE = WS_FIN + (size_t)T * 2048 * 2;
constexpr size_t WS_Q = WS_FGATE + (size_t)T * 2048 * 2;
constexpr size_t WS_K = WS_Q + (size_t)T * 1024 * 2;
constexpr size_t WS_V = WS_K + (size_t)T * 1024 * 2;
constexpr size_t WS_GG = WS_V + (size_t)T * 2048 * 2;
constexpr size_t WS_AB = WS_GG + (size_t)T * 2048 * 2;
constexpr size_t WS_OF = WS_AB + (size_t)T * 32 * 2;
constexpr size_t WS_OB = WS_OF + (size_t)T * 2048 * 2;
constexpr size_t WS_KDG = WS_OB + (size_t)T * 2048 * 2;
constexpr size_t WS_DECG = WS_KDG + (size_t)2 * T * 1024 * 2;
constexpr size_t WS_QTG = WS_FIN;
constexpr size_t WS_KTG = WS_FGATE;
constexpr size_t WS_END = WS_DECG + (size_t)2 * (T / 64) * 1024 * 4;

struct Args {
    const float* x_prompt; const float* x_sample; const float* st_f; const float* st_b; const float* c; const float* c_ctx;
    const float* ada_w; const float* ada_b; const float* norm_w; const float* w_in; const float* w_alpha; const float* b_alpha;
    const float* w_fourier; const float* gla_norm_w; const float* w_out; const float* final_norm_w;
    float* out; unsigned char* ws;
};

__device__ __forceinline__ unsigned cvt_pk_bf16(float lo, float hi) { unsigned r; asm volatile("v_cvt_pk_bf16_f32 %0, %1, %2" : "=v"(r) : "v"(lo), "v"(hi)); return r; }
__device__ __forceinline__ float bf2f(unsigned short b) { return __uint_as_float(((unsigned)b) << 16); }
__device__ __forceinline__ float bflo(unsigned w) { return __uint_as_float(w << 16); }
__device__ __forceinline__ float bfhi(unsigned w) { return __uint_as_float(w & 0xffff0000u); }
__device__ __forceinline__ float silu_f(float x) { return x / (1.0f + __expf(-x)); }
__device__ __forceinline__ float wave_sum(float v) {
#pragma unroll
    for (int o = 32; o >= 1; o >>= 1) v += __shfl_xor(v, o);
    return v; }

__device__ __forceinline__ int fresh_tid() { int t = threadIdx.x; asm volatile("" : "+v"(t)); return t; }
#define XB_TMO      128
#define XB_XCNT(j)  (256  + 64 * (j))
#define XB_XSUB(j)  (1280 + 64 * (j))
#define XB_XGEN(j)  (2304 + 64 * (j))
#define XB_TOP      3328
#define XB_TOPGEN   3392
#define XCD_BAR_WORDS 3456
#define XB_SPIN_CAP (1u << 18)
#define LAS __attribute__((address_space(3)))

__device__ __forceinline__ unsigned xb_ld(unsigned* p)              { return __hip_atomic_load(p, __ATOMIC_RELAXED, __HIP_MEMORY_SCOPE_AGENT); }
__device__ __forceinline__ unsigned xb_add(unsigned* p, unsigned v) { return __hip_atomic_fetch_add(p, v, __ATOMIC_RELAXED, __HIP_MEMORY_SCOPE_AGENT); }
__device__ __forceinline__ unsigned xb_xcc_id() { return (unsigned)__builtin_amdgcn_s_getreg((3 << 11) | 20) & 0xFu; }
#define XB_SPIN(cond, bar) do { unsigned _sp = 0; while (cond) { __builtin_amdgcn_s_sleep(1); \
    if ((++_sp & 255u) == 0u) { if (xb_ld(&(bar)[XB_TMO])) break; if (_sp > XB_SPIN_CAP) { atomicAdd(&(bar)[XB_TMO], 1u); break; } } } } while (0)

struct XcdBarrier {
    unsigned* bar; unsigned x;
    volatile LAS unsigned* st;
};

__device__ __forceinline__ XcdBarrier xcd_barrier_post(unsigned* bar, volatile LAS unsigned* st) {
    XcdBarrier b; b.bar = bar; b.x = xb_xcc_id(); b.st = st;
    if (threadIdx.x == 0) (void)xb_add(&bar[XB_XCNT(b.x)], 1u);
    return b;
}
__device__ __forceinline__ void xcd_barrier_complete(unsigned* bar, unsigned x, unsigned& nloc, unsigned& nx) {
    const unsigned G = gridDim.x * gridDim.y * gridDim.z;
    unsigned sum, cnt, mine, sp = 0u;
    for (;;) {
        sum = 0u; cnt = 0u; mine = 0u;
#pragma unroll
        for (unsigned j = 0; j < 16; ++j) { const unsigned c = xb_ld(&bar[XB_XCNT(j)]); sum += c; cnt += (c > 0u) ? 1u : 0u; mine = (j == x) ? c : mine; }
        if (sum == G) break;
        __builtin_amdgcn_s_sleep(1);
        if ((++sp & 255u) == 0u) { if (xb_ld(&bar[XB_TMO])) break; if (sp > XB_SPIN_CAP) { atomicAdd(&bar[XB_TMO], 1u); break; } }
    }
    nloc = mine > 0u ? mine : 1u; nx = cnt > 0u ? cnt : 1u;
}

__device__ __forceinline__ void xcd_barrier(const XcdBarrier& b) {
    asm volatile("s_waitcnt vmcnt(0)" ::: "memory");
    __syncthreads();
    if (threadIdx.x == 0) {
        unsigned* bar = b.bar;
        __builtin_amdgcn_s_waitcnt(0);
        unsigned nloc = b.st[0], nx = b.st[1];
        if (nloc == 0u) { xcd_barrier_complete(bar, b.x, nloc, nx); b.st[0] = nloc; b.st[1] = nx; }
        const unsigned old = xb_add(&bar[XB_XSUB(b.x)], 1u);
        const unsigned gen = old / nloc;
        if (old + 1u == (gen + 1u) * nloc) {
            __builtin_amdgcn_fence(__ATOMIC_RELEASE, "agent");
            asm volatile("s_waitcnt vmcnt(0)" ::: "memory");
            const unsigned og = xb_add(&bar[XB_TOP], 1u);
            const unsigned tg = og / nx;
            if (og + 1u == (tg + 1u) * nx) xb_add(&bar[XB_TOPGEN], 1u);
            else XB_SPIN(xb_ld(&bar[XB_TOPGEN]) == tg, bar);
            __builtin_amdgcn_fence(__ATOMIC_ACQUIRE, "agent");
            xb_add(&bar[XB_XGEN(b.x)], 1u);
            asm volatile("s_waitcnt vmcnt(0)" ::: "memory");
        } else {
            XB_SPIN(xb_ld(&bar[XB_XGEN(b.x)]) == gen, bar);
            __builtin_amdgcn_fence(__ATOMIC_ACQUIRE, "agent");
            asm volatile("s_waitcnt vmcnt(0)" ::: "memory");
        }
    }
    __syncthreads();
}

namespace pg8 {
#define PG8_LAS __attribute__((address_space(3)))
constexpr int BM = 256, BK = 64, HALF = 128, HTB = HALF * BK * 2, STAGE_BYTES = 8 * HTB, NXCD = 8, WGM = 8;
__host__ __device__ __forceinline__ int lds_byte(int r, int c) { const int st = (r >> 4) * 2 + (c >> 5), rr = r & 15, cc = c & 31, ob = rr * 64 + cc * 2; return st * 1024 + (ob ^ (((ob >> 9) & 1) << 5)); }
__host__ __device__ __forceinline__ void stage_rc(int b, int& R, int& C) { const int st = b / 1024, sb = b % 1024, swz = sb ^ (((sb >> 9) & 1) << 5); R = (st >> 1) * 16 + swz / 64; C = (st & 1) * 32 + (swz % 64) / 2; }
__host__ __device__ __forceinline__ int perm32(int rho) { const int n = rho >> 4, i = rho & 15; return 8 * (i >> 2) + 4 * n + (i & 3); }
struct Unit { const char* a; const char* b; int pm, pn, bz; };
struct BOrder {
    int nM, nN, nB, nB2, G, c, nsplit; const char* A; const char* B; size_t sA1, sA2, sB1, sB2, tA, tB, aN, bM;
    __device__ __forceinline__ bool next(int i, Unit& u) const {
        const long L = (long)i * G + c; const int nwg = nB * nM * nN; if (L >= nwg) return false;
        int wgid = (int)L; { const int q = nwg / NXCD, r = nwg % NXCD, xcd = wgid % NXCD, off = wgid / NXCD; wgid = (xcd < r ? xcd * (q + 1) : r * (q + 1) + (xcd - r) * q) + off; }
        const int per = nM * nN, bz = wgid / per; wgid -= bz * per;
        const int nig = WGM * nN, gid = wgid / nig, fm = gid * WGM, gsz = (nM - fm) < WGM ? (nM - fm) : WGM;
        u.pm = fm + ((wgid % nig) % gsz); u.pn = (wgid % nig) / gsz; u.bz = bz;
        const int b1 = bz / nB2, b2 = bz % nB2;
        u.a = A + (size_t)b1 * sA1 + (size_t)b2 * sA2 + (size_t)u.pm * tA + (size_t)(u.pn / nsplit) * aN; u.b = B + (size_t)b1 * sB1 + (size_t)b2 * sB2 + (size_t)(u.pn % nsplit) * tB + (size_t)u.pm * bM; return true;
    }
};
template <class Epi, class Sched>
__device__ __forceinline__ void gemm_phase(PG8_LAS unsigned char* lds, const int lda, const int ldb, const int K, const Sched& S, const Epi& E) {
    const int tid = fresh_tid(), wid = __builtin_amdgcn_readfirstlane(tid >> 6), lane = tid & 63, wr = wid >> 2, wc = wid & 3, fr = lane & 15, fq = lane >> 4;
    const int nt = K / BK;
    unsigned voffA[2], voffB[2];
#pragma unroll
    for (int i = 0; i < 2; ++i) { int R, C; stage_rc(tid * 16 + i * 8192, R, C); const int Rb = Epi::PERM ? ((R & ~31) + perm32(R & 31)) : R;
        voffA[i] = (unsigned)(R * lda + C) * 2u; voffB[i] = (unsigned)(Rb * ldb + C) * 2u; }
    const size_t kstep = (size_t)(BK * 2);
    const size_t hsA = (size_t)HALF * lda * 2, hsB = (size_t)HALF * ldb * 2;
    const unsigned ldsw = (unsigned)wid * 1024u;
    const int aoff = lds_byte(wr * 64 + fr, fq * 8), boff = lds_byte(wc * 32 + fr, fq * 8);
#define PG8_SA(b, h) (((b) * 2 + (h)) * HTB)
#define PG8_SB(b, h) ((4 + (b) * 2 + (h)) * HTB)
#define PG8_STAGE(bufoff, gbase, voff) do { _Pragma("unroll") for (int _i = 0; _i < 2; ++_i) \
        __builtin_amdgcn_global_load_lds((const unsigned*)((const char*)(gbase) + (voff)[_i]), (PG8_LAS unsigned*)(lds + (bufoff) + ldsw + _i * 8192), 16, 0, 0); } while (0)
#define PG8_LDA(dst, b, h) do { _Pragma("unroll") for (int m = 0; m < 4; ++m) _Pragma("unroll") for (int k = 0; k < 2; ++k) dst[m][k] = *(const PG8_LAS bf16x8*)(lds + PG8_SA(b, h) + aoff + m * 2048 + k * 1024); } while (0)
#define PG8_LDB(dst, b, h) do { _Pragma("unroll") for (int n = 0; n < 2; ++n) _Pragma("unroll") for (int k = 0; k < 2; ++k) dst[n][k] = *(const PG8_LAS bf16x8*)(lds + PG8_SB(b, h) + boff + n * 2048 + k * 1024); } while (0)
#define PG8_MMA(ai, bj, At, Bt) do { __builtin_amdgcn_s_setprio(1); _Pragma("unroll") for (int m = 0; m < 4; ++m) _Pragma("unroll") for (int n = 0; n < 2; ++n) _Pragma("unroll") for (int k = 0; k < 2; ++k) \
        acc[ai][bj][m][n] = __builtin_amdgcn_mfma_f32_16x16x32_bf16(Bt[n][k], At[m][k], acc[ai][bj][m][n], 0, 0, 0); __builtin_amdgcn_s_setprio(0); } while (0)
#define PG8_WAIT_V(n) asm volatile("s_waitcnt vmcnt(" #n ")" ::: "memory")
#define PG8_WAIT_L(n) asm volatile("s_waitcnt lgkmcnt(" #n ")" ::: "memory")
#define PG8_BAR __builtin_amdgcn_s_barrier()
#define PG8_SCHED __builtin_amdgcn_sched_barrier(0)
    Unit cur, nxt; int ui = 0;
    if (!S.next(0, cur)) return;
    f32x4 acc[2][2][4][2];
#pragma unroll
    for (int a = 0; a < 2; ++a)
#pragma unroll
        for (int b = 0; b < 2; ++b)
#pragma unroll
            for (int m = 0; m < 4; ++m)
#pragma unroll
                for (int n = 0; n < 2; ++n) acc[a][b][m][n] = (f32x4){0.f, 0.f, 0.f, 0.f};
    bf16x8 At[4][2], B0[2][2], B1[2][2];
    const char* cA = cur.a; const char* cB = cur.b;
    PG8_STAGE(PG8_SB(0, 0), cB, voffB); PG8_STAGE(PG8_SA(0, 0), cA, voffA); PG8_STAGE(PG8_SB(0, 1), cB + hsB, voffB); PG8_STAGE(PG8_SA(0, 1), cA + hsA, voffA);
    if (wr == 1) PG8_BAR;
    PG8_WAIT_V(4); PG8_BAR;
    PG8_STAGE(PG8_SB(1, 0), cB + kstep, voffB); PG8_STAGE(PG8_SA(1, 0), cA + kstep, voffA); PG8_STAGE(PG8_SB(1, 1), cB + hsB + kstep, voffB);
    PG8_WAIT_V(6); PG8_BAR;
    for (;;) {
        const bool has_next = S.next(ui + 1, nxt);
        const char* nA = has_next ? nxt.a : cA; const char* nB = has_next ? nxt.b : cB;
        for (int t = 0; t < nt; t += 2) {
            const bool last = (t == nt - 2);
            const char* a1 = cA + (size_t)(t + 1) * kstep;
            const char* a2 = last ? nA : cA + (size_t)(t + 2) * kstep; const char* b2 = last ? nB : cB + (size_t)(t + 2) * kstep;
            const char* a3 = a2 + kstep; const char* b3 = b2 + kstep;
            PG8_LDB(B0, 0, 0); PG8_SCHED; PG8_LDA(At, 0, 0); PG8_STAGE(PG8_SA(1, 1), a1 + hsA, voffA);
            PG8_WAIT_L(8); PG8_BAR; PG8_WAIT_L(0); PG8_MMA(0, 0, At, B0); PG8_BAR; PG8_SCHED;
            PG8_LDB(B1, 0, 1); PG8_STAGE(PG8_SB(0, 0), b2, voffB);
            PG8_BAR; PG8_WAIT_L(0); PG8_MMA(0, 1, At, B1); PG8_BAR;
            PG8_LDA(At, 0, 1); PG8_STAGE(PG8_SA(0, 0), a2, voffA);
            PG8_BAR; PG8_WAIT_L(0); PG8_MMA(1, 0, At, B0); PG8_BAR; PG8_SCHED;
            PG8_STAGE(PG8_SB(0, 1), b2 + hsB, voffB);
            PG8_WAIT_V(6); PG8_BAR; PG8_MMA(1, 1, At, B1); PG8_BAR;
            PG8_LDB(B0, 1, 0); PG8_SCHED; PG8_LDA(At, 1, 0); PG8_STAGE(PG8_SA(0, 1), a2 + hsA, voffA);
            PG8_WAIT_L(8); PG8_BAR; PG8_WAIT_L(0); PG8_MMA(0, 0, At, B0); PG8_BAR; PG8_SCHED;
            PG8_LDB(B1, 1, 1); PG8_STAGE(PG8_SB(1, 0), b3, voffB);
            PG8_BAR; PG8_WAIT_L(0); PG8_MMA(0, 1, At, B1); PG8_BAR;
            PG8_LDA(At, 1, 1); PG8_STAGE(PG8_SA(1, 0), a3, voffA);
            PG8_BAR; PG8_WAIT_L(0); PG8_MMA(1, 0, At, B0); PG8_BAR; PG8_SCHED;
            PG8_STAGE(PG8_SB(1, 1), b3 + hsB, voffB);
            PG8_WAIT_V(6); PG8_BAR; PG8_MMA(1, 1, At, B1); PG8_BAR;
        }
        E(acc, cur, wr, wc, fr, fq);
        if (!has_next) break;
#pragma unroll
        for (int a = 0; a < 2; ++a)
#pragma unroll
            for (int b = 0; b < 2; ++b)
#pragma unroll
                for (int m = 0; m < 4; ++m)
#pragma unroll
                    for (int n = 0; n < 2; ++n) acc[a][b][m][n] = (f32x4){0.f, 0.f, 0.f, 0.f};
        cur = nxt; cA = nA; cB = nB; ++ui;
    }
    PG8_WAIT_V(0);
    if (wr == 0) PG8_BAR;
    PG8_BAR;
#undef PG8_SA
#undef PG8_SB
#undef PG8_STAGE
#undef PG8_LDA
#undef PG8_LDB
#undef PG8_MMA
#undef PG8_WAIT_V
#undef PG8_WAIT_L
#undef PG8_BAR
#undef PG8_SCHED
}
}

using pg8::Unit; using pg8::BOrder;
struct TileDst { bf16_t* p; int ld; int ncols; const bf16_t* gate; int gld; int cmode, cpar, rmode, rpar; };
template <class F, bool GATE> struct EpiB {
    static constexpr bool PERM = true; F f;
    __device__ __forceinline__ void operator()(const f32x4 (&acc)[2][2][4][2], const Unit& u, int wr, int wc, int fr, int fq) const {
        const TileDst d = f(u);
        const int r0 = wr * 64 + fr, c0 = wc * 32 + 8 * fq;
#pragma unroll
        for (int ai = 0; ai < 2; ++ai)
#pragma unroll
            for (int m = 0; m < 4; ++m) { const int row = r0 + ai * 128 + m * 16; const int drow = d.rmode ? ((row & 63) * 64 + d.rpar + (row >> 6)) : row;
#pragma unroll
                for (int bj = 0; bj < 2; ++bj) { const int col = c0 + bj * 128; int dcol = col;
                    if (d.cmode == 1) dcol = (col >> 6) * 128 + (col & 63); else if (d.cmode == 2) { const int nn = d.cpar + col; dcol = (nn >> 4) * 128 + ((nn >> 3) & 1) * 64; }
                    if (col < d.ncols) {
                        f32x4 v0 = acc[ai][bj][m][0], v1 = acc[ai][bj][m][1];
                        if (GATE) { const u32x4 g = *(const u32x4*)(d.gate + (size_t)row * d.gld + col);
                            v0[0] *= silu_f(bflo(g.x)); v0[1] *= silu_f(bfhi(g.x)); v0[2] *= silu_f(bflo(g.y)); v0[3] *= silu_f(bfhi(g.y));
                            v1[0] *= silu_f(bflo(g.z)); v1[1] *= silu_f(bfhi(g.z)); v1[2] *= silu_f(bflo(g.w)); v1[3] *= silu_f(bfhi(g.w)); }
                        u32x4 w; w.x = cvt_pk_bf16(v0[0], v0[1]); w.y = cvt_pk_bf16(v0[2], v0[3]); w.z = cvt_pk_bf16(v1[0], v1[1]); w.w = cvt_pk_bf16(v1[2], v1[3]);
                        *(u32x4*)(d.p + (size_t)drow * d.ld + dcol) = w; } } }
    }
};
struct DstInProj { unsigned char* ws;
    __device__ __forceinline__ TileDst operator()(const Unit& u) const { const int pn = u.pn; size_t off; int ld, co, nc = 256;
        if (pn < 8) { off = WS_FIN; ld = 2048; co = pn * 256; } else if (pn < 16) { off = WS_FGATE; ld = 2048; co = (pn - 8) * 256; }
        else if (pn < 20) { off = WS_Q; ld = 1024; co = (pn - 16) * 256; } else if (pn < 24) { off = WS_K; ld = 1024; co = (pn - 20) * 256; }
        else if (pn < 32) { off = WS_V; ld = 2048; co = (pn - 24) * 256; } else if (pn < 40) { off = WS_GG; ld = 2048; co = (pn - 32) * 256; }
        else { off = WS_AB; ld = 32; co = 0; nc = 32; }
        TileDst d; d.cmode = 0; d.cpar = 0; d.rmode = 0; d.rpar = 0; d.p = (bf16_t*)(ws + off) + (size_t)u.pm * 256 * ld + co; d.ld = ld; d.ncols = nc; d.gate = nullptr; d.gld = 0; return d; } };
struct DstChDft { unsigned char* ws;
    __device__ __forceinline__ TileDst operator()(const Unit& u) const { const int g = u.bz, part = u.pm >> 1, cp0 = (u.pm & 1) * 256, pn = u.pn; TileDst d; d.cmode = 0; d.cpar = 0; d.rmode = 0; d.rpar = 0; d.ncols = 256; d.gate = nullptr; d.gld = 0;
        if (pn < 32) { d.ld = 16384; d.p = (bf16_t*)(ws + WS_ZTC) + (size_t)(g * 512 + cp0) * 16384 + pn * 512 + part * 256; }
        else { const int lt = (pn - 32) * 256, b = lt >> 12, l0 = lt & 4095; d.ld = 65536; d.cmode = 1; d.p = (bf16_t*)(ws + WS_ZTL) + (size_t)(g * 512 + cp0) * 65536 + b * 8192 + (l0 >> 6) * 128 + part * 64; }
        return d; } };
struct DstPosCtx { unsigned char* ws;
    __device__ __forceinline__ TileDst operator()(const Unit& u) const { const int b = u.bz >> 2, g = u.bz & 3; TileDst d; d.cmode = 0; d.cpar = 0; d.rmode = 0; d.rpar = 0; d.ncols = 256; d.gate = nullptr; d.gld = 0; d.ld = 2048;
        d.p = (bf16_t*)(ws + WS_RE) + (size_t)(b * 256) * 2048 + g * 512 + u.pn * 256; return d; } };
struct DstLatA { unsigned char* ws;
    __device__ __forceinline__ TileDst operator()(const Unit& u) const { TileDst d; d.cmode = 2; d.cpar = (u.pn & 3) * 256; d.rmode = 0; d.rpar = 0; d.ncols = 256; d.gate = nullptr; d.gld = 0; d.ld = 8192;
        d.p = (bf16_t*)(ws + WS_OF) + (size_t)(u.pm * 256) * 8192 + (u.pn >> 2) * 8; return d; } };
struct DstLatB { unsigned char* ws;
    __device__ __forceinline__ TileDst operator()(const Unit& u) const { const int b = u.bz >> 2, g = u.bz & 3; TileDst d; d.cmode = 0; d.cpar = 0; d.rmode = 1; d.rpar = u.pm * 4; d.ncols = 256; d.gate = nullptr; d.gld = 0; d.ld = 2048;
        d.p = (bf16_t*)(ws + WS_RE) + (size_t)(TC + b * 4096) * 2048 + g * 512 + u.pn * 256; return d; } };
struct DstWf { unsigned char* ws;
    __device__ __forceinline__ TileDst operator()(const Unit& u) const { const int g = u.bz; TileDst d; d.cmode = 0; d.cpar = 0; d.rmode = 0; d.rpar = 0; d.ncols = 256; d.ld = 4096; d.gld = 2048;
        d.p = (bf16_t*)(ws + WS_MIX) + (size_t)(u.pm * 256) * 4096 + g * 512 + u.pn * 256;
        d.gate = (const bf16_t*)(ws + WS_FGATE) + (size_t)(u.pm * 256) * 2048 + g * 512 + u.pn * 256; return d; } };
struct DstOut { unsigned char* ws;
    __device__ __forceinline__ TileDst operator()(const Unit& u) const { TileDst d; d.cmode = 0; d.cpar = 0; d.rmode = 0; d.rpar = 0; d.ncols = 256; d.gate = nullptr; d.gld = 0; d.ld = 4096;
        d.p = (bf16_t*)(ws + WS_OF) + (size_t)(u.pm * 256) * 4096 + u.pn * 256; return d; } };
struct EpiOut {
    static constexpr bool PERM = false; const float* xp; const float* xs; const float* modv; float* out;
    __device__ __forceinline__ void operator()(const f32x4 (&acc)[2][2][4][2], const Unit& u, int wr, int wc, int fr, int fq) const {
        const int t0 = u.pm * 256; const int bidx = t0 < TC ? 0 : 1 + ((t0 - TC) >> 12);
        const float* x = (t0 < TC ? xp + (size_t)t0 * 4096 : xs + (size_t)(t0 - TC) * 4096) + u.pn * 256;
        const float* gt = modv + bidx * 12288 + 8192 + u.pn * 256; float* o = out + (size_t)t0 * 4096 + u.pn * 256;
        const int r0 = wr * 64 + fr, c0 = wc * 32 + 4 * fq;
#pragma unroll
        for (int ai = 0; ai < 2; ++ai)
#pragma unroll
            for (int m = 0; m < 4; ++m) { const size_t ro = (size_t)(r0 + ai * 128 + m * 16) * 4096;
#pragma unroll
                for (int bj = 0; bj < 2; ++bj)
#pragma unroll
                    for (int n = 0; n < 2; ++n) { const int col = c0 + bj * 128 + n * 16; const f32x4 g = *(const f32x4*)(gt + col); const f32x4 xv = *(const f32x4*)(x + ro + col);
                        *(f32x4*)(o + ro + col) = xv + g * acc[ai][bj][m][n]; } }
    }
};

__device__ __forceinline__ void store_bf8(bf16_t* p, const float (&e)[8]) { u32x4 w; w.x = cvt_pk_bf16(e[0], e[1]); w.y = cvt_pk_bf16(e[2], e[3]); w.z = cvt_pk_bf16(e[4], e[5]); w.w = cvt_pk_bf16(e[6], e[7]); *(u32x4*)p = w; }
__device__ __forceinline__ void phase0(const Args& a, LAS unsigned char* lds, const int G, const int c) {
    const int tid = fresh_tid(), wid = tid >> 6, lane = tid & 63;
    float* modv = (float*)(a.ws + WS_MODV);
    {   LAS float* sv = (LAS float*)(lds + wid * 4608);
        for (int task = c * 8 + wid; task < 1536; task += G * 8) {
            const int cb = task % 48, ks = task / 48, k0 = ks * 128;
            for (int e = lane; e < 9 * 128; e += 64) { const int bi = e >> 7, kk = e & 127; const float x = bi == 0 ? a.c_ctx[k0 + kk] : a.c[(bi - 1) * 4096 + k0 + kk]; sv[e] = silu_f(x); }
            f32x4 acc[9];
#pragma unroll
            for (int bi = 0; bi < 9; ++bi) acc[bi] = (f32x4){0.f, 0.f, 0.f, 0.f};
            const float* wp = a.ada_w + (size_t)k0 * 12288 + cb * 256 + lane * 4;
#pragma unroll 8
            for (int kk = 0; kk < 128; ++kk) { const f32x4 w = *(const f32x4*)(wp + (size_t)kk * 12288);
#pragma unroll
                for (int bi = 0; bi < 9; ++bi) acc[bi] += sv[bi * 128 + kk] * w; }
            const int col = cb * 256 + lane * 4;
#pragma unroll
            for (int bi = 0; bi < 9; ++bi)
#pragma unroll
                for (int e = 0; e < 4; ++e) { const float v = acc[bi][e] + (ks == 0 ? a.ada_b[col + e] : 0.f); atomicAdd(modv + bi * 12288 + col + e, v); }
        }
    }
    __syncthreads();
    {   LAS float* tile = (LAS float*)(lds + 40960);
        for (int tt = c; tt < 2624 + 1024 + 64; tt += G) {
            const float* src; bf16_t* dst; int N, Kd, kt, ng;
            if (tt < 2624) { kt = tt / 41; ng = tt % 41; src = a.w_in; N = NIN; Kd = 4096; dst = (bf16_t*)(a.ws + WS_WINT); }
            else if (tt < 3648) { const int t2 = tt - 2624; kt = t2 >> 4; ng = t2 & 15; src = a.w_out; N = 4096; Kd = 4096; dst = (bf16_t*)(a.ws + WS_WOUTT); }
            else { const int t2 = tt - 3648, g = t2 >> 4, r = t2 & 15; kt = r >> 1; ng = r & 1; src = a.w_fourier + (size_t)g * 512 * 512; N = 512; Kd = 512; dst = (bf16_t*)(a.ws + WS_WFT) + (size_t)g * 512 * 512; }
            const int k0 = kt * 64, n0 = ng * 256;
            {   const int r = tid >> 4, c4 = (tid & 15) * 4; f32x4 v[4][2];
#pragma unroll
                for (int sub = 0; sub < 4; ++sub)
#pragma unroll
                    for (int rr = 0; rr < 2; ++rr) { v[sub][rr] = (f32x4){0.f, 0.f, 0.f, 0.f}; if (n0 + sub * 64 + c4 < N) v[sub][rr] = *(const f32x4*)(src + (size_t)(k0 + r + rr * 32) * N + n0 + sub * 64 + c4); }
#pragma unroll
                for (int sub = 0; sub < 4; ++sub)
#pragma unroll
                    for (int rr = 0; rr < 2; ++rr) { LAS float* tp = tile + sub * 4160 + (r + rr * 32) * 65 + c4; tp[0] = v[sub][rr][0]; tp[1] = v[sub][rr][1]; tp[2] = v[sub][rr][2]; tp[3] = v[sub][rr][3]; } }
            __syncthreads();
            {   const int n = tid >> 3, kq = (tid & 7) * 8;
#pragma unroll
                for (int sub = 0; sub < 4; ++sub) { float e[8];
#pragma unroll
                    for (int i = 0; i < 8; ++i) e[i] = tile[sub * 4160 + (kq + i) * 65 + n];
                    store_bf8(dst + (size_t)(n0 + sub * 64 + n) * Kd + k0 + kq, e); } }
            __syncthreads();
        }
    }
    {   const size_t nth = (size_t)G * 512, gt = (size_t)c * 512 + tid;
        bf16_t* dch = (bf16_t*)(a.ws + WS_DCH); bf16_t* pctx = (bf16_t*)(a.ws + WS_PCTX); bf16_t* plat = (bf16_t*)(a.ws + WS_PLAT);
        for (size_t e = gt; e < 65536; e += nth) { const int r = (int)(e >> 6), c0 = (int)(e & 63) * 8, rr = r & 511; const bool sn = r >= 512; float v[8];
#pragma unroll
            for (int i = 0; i < 8; ++i) { const int p = (rr * (c0 + i)) & 511; const float ang = (float)p * (2.0f / 512.0f); v[i] = (sn ? sinpif(ang) : cospif(ang)) * 0.044194173824159216f; }
            store_bf8(dch + e * 8, v); }
        for (size_t e = gt; e < 16384; e += nth) { const int r = (int)(e >> 6), k0 = (int)(e & 63) * 8; const bool sn = k0 >= 256; float v[8];
#pragma unroll
            for (int i = 0; i < 8; ++i) { const int p = (r * ((k0 + i) & 255)) & 255; const float ang = (float)p * (2.0f / 256.0f); v[i] = (sn ? -sinpif(ang) : cospif(ang)) * 0.0625f; }
            store_bf8(pctx + e * 8, v); }
        bf16_t* ba = plat; bf16_t* ab = plat + (size_t)1024 * 1024;
        for (size_t e = gt; e < 131072; e += nth) { const int nn = (int)(e >> 7), k0 = (int)(e & 127) * 8; const int c2p = nn >> 4, comp = (nn >> 3) & 1, rl = nn & 7; float v[8];
#pragma unroll
            for (int i = 0; i < 8; ++i) { const int kk = k0 + i, rl2 = kk >> 7, part = (kk >> 6) & 1, c2 = kk & 63; const float ang = (float)((c2 * c2p) & 63) * (2.0f / 64.0f); const float cs = cospif(ang), sn = sinpif(ang);
                const float f = comp == 0 ? (part == 0 ? cs : -sn) : (part == 0 ? sn : cs); v[i] = rl == rl2 ? f * 0.125f : 0.f; }
            store_bf8(ba + e * 8, v); }
        for (size_t e = gt; e < 16384; e += nth) { const int ii = (int)(e >> 6), k0 = (int)(e & 63) * 8; const int c2l = ii >> 6, rp = ii & 63; float v[8];
#pragma unroll
            for (int i = 0; i < 8; ++i) { const int kk = k0 + i, c2l2 = kk >> 7, comp = (kk >> 6) & 1, r = kk & 63; const float ang = (float)((r * rp) & 63) * (2.0f / 64.0f);
                const float f = comp == 0 ? cospif(ang) : -sinpif(ang); v[i] = c2l == c2l2 ? f * 0.125f : 0.f; }
            store_bf8(ab + e * 8, v); }
    }
}

__device__ __forceinline__ void phase_h(const Args& a, const int G, const int c) {
    const int tid = fresh_tid(), wid = tid >> 6, lane = tid & 63;
    const float* modv = (const float*)(a.ws + WS_MODV); bf16_t* H = (bf16_t*)(a.ws + WS_H);
    for (int t = c * 8 + wid; t < T; t += G * 8) {
        const float* x = t < TC ? a.x_prompt + (size_t)t * 4096 : a.x_sample + (size_t)(t - TC) * 4096;
        const int bidx = t < TC ? 0 : 1 + ((t - TC) >> 12); const float* mv = modv + bidx * 12288;
        f32x4 v[16]; float ss = 0.f;
#pragma unroll
        for (int it = 0; it < 16; ++it) { v[it] = *(const f32x4*)(x + it * 256 + lane * 4); ss += v[it][0] * v[it][0] + v[it][1] * v[it][1] + v[it][2] * v[it][2] + v[it][3] * v[it][3]; }
        ss = wave_sum(ss); const float rstd = rsqrtf(ss * (1.0f / 4096.0f) + 1e-6f);
#pragma unroll
        for (int it = 0; it < 16; ++it) { const int col = it * 256 + lane * 4; const f32x4 nw = *(const f32x4*)(a.norm_w + col), sh = *(const f32x4*)(mv + col), sc = *(const f32x4*)(mv + 4096 + col);
            const f32x4 hv = v[it] * rstd * nw * (1.0f + sc) + sh; u32x2 w; w.x = cvt_pk_bf16(hv[0], hv[1]); w.y = cvt_pk_bf16(hv[2], hv[3]); *(u32x2*)(H + (size_t)t * 4096 + col) = w; }
    }
}
__device__ __forceinline__ void phase_glapost(const Args& a, const int G, const int c) {
    const int tid = fresh_tid(), wid = tid >> 6, lane = tid & 63;
    const bf16_t* OF = (const bf16_t*)(a.ws + WS_OF); const bf16_t* OB = (const bf16_t*)(a.ws + WS_OB); const bf16_t* GG = (const bf16_t*)(a.ws + WS_GG); bf16_t* MIX = (bf16_t*)(a.ws + WS_MIX);
    for (int task = c * 8 + wid; task < T * 4; task += G * 8) { const int t = task >> 2, h = task & 3, col = h * 512 + lane * 8;
        const u32x4 f = *(const u32x4*)(OF + (size_t)t * 2048 + col), b = *(const u32x4*)(OB + (size_t)t * 2048 + col), g = *(const u32x4*)(GG + (size_t)t * 2048 + col);
        float o[8]; o[0] = bflo(f.x) + bflo(b.x); o[1] = bfhi(f.x) + bfhi(b.x); o[2] = bflo(f.y) + bflo(b.y); o[3] = bfhi(f.y) + bfhi(b.y); o[4] = bflo(f.z) + bflo(b.z); o[5] = bfhi(f.z) + bfhi(b.z); o[6] = bflo(f.w) + bflo(b.w); o[7] = bfhi(f.w) + bfhi(b.w);
        float gg[8]; gg[0] = bflo(g.x); gg[1] = bfhi(g.x); gg[2] = bflo(g.y); gg[3] = bfhi(g.y); gg[4] = bflo(g.z); gg[5] = bfhi(g.z); gg[6] = bflo(g.w); gg[7] = bfhi(g.w);
        float ss = 0.f;
#pragma unroll
        for (int i = 0; i < 8; ++i) ss += o[i] * o[i];
        ss = wave_sum(ss); const float rstd = rsqrtf(ss * (1.0f / 512.0f) + 1e-6f);
        const f32x4 w0 = *(const f32x4*)(a.gla_norm_w + col), w1 = *(const f32x4*)(a.gla_norm_w + col + 4); float e[8];
#pragma unroll
        for (int i = 0; i < 8; ++i) e[i] = o[i] * rstd * (i < 4 ? w0[i & 3] : w1[i & 3]) * silu_f(gg[i]);
        store_bf8(MIX + (size_t)t * 4096 + 2048 + col, e); }
}
__device__ __forceinline__ void phase_final(const Args& a, const int G, const int c) {
    const int tid = fresh_tid(), wid = tid >> 6, lane = tid & 63;
    const float* modv = (const float*)(a.ws + WS_MODV); const bf16_t* OUTB = (const bf16_t*)(a.ws + WS_OF);
    for (int t = c * 8 + wid; t < T; t += G * 8) {
        const float* x = t < TC ? a.x_prompt + (size_t)t * 4096 : a.x_sample + (size_t)(t - TC) * 4096;
        const int bidx = t < TC ? 0 : 1 + ((t - TC) >> 12); const float* gt = modv + bidx * 12288 + 8192; float* y = a.out + (size_t)t * 4096;
        f32x4 v[16]; float ss = 0.f;
#pragma unroll
        for (int it = 0; it < 16; ++it) { const int col = it * 256 + lane * 4; const f32x4 xv = *(const f32x4*)(x + col); const f32x4 g = *(const f32x4*)(gt + col); const u32x2 ob = *(const u32x2*)(OUTB + (size_t)t * 4096 + col);
            v[it] = xv + g * (f32x4){bflo(ob.x), bfhi(ob.x), bflo(ob.y), bfhi(ob.y)}; ss += v[it][0] * v[it][0] + v[it][1] * v[it][1] + v[it][2] * v[it][2] + v[it][3] * v[it][3]; }
        ss = wave_sum(ss); const float rstd = rsqrtf(ss * (1.0f / 4096.0f) + 1e-6f);
#pragma unroll
        for (int it = 0; it < 16; ++it) { const int col = it * 256 + lane * 4; const f32x4 nw = *(const f32x4*)(a.final_norm_w + col); *(f32x4*)(y + col) = v[it] * rstd * nw; }
    }
}

__device__ __forceinline__ f32x4 mfma16(bf16x8 a, bf16x8 b, f32x4 c) { return __builtin_amdgcn_mfma_f32_16x16x32_bf16(a, b, c, 0, 0, 0); }
__device__ __forceinline__ unsigned short f2bf(float f) { return (unsigned short)(cvt_pk_bf16(f, 0.f) & 0xffffu); }
__device__ __forceinline__ void pre_decode(const int task, int& chunk, int& s, int& L, int& base) {
    if (task < 4096) { chunk = task & 63; s = task >> 6; L = 4096; base = TC + (s >> 3) * 4096; } else { const int t2 = task - 4096; chunk = t2 & 3; s = t2 >> 2; L = 256; base = (s >> 3) * 256; } }
__device__ __forceinline__ void phase_gla_pre(const Args& a, LAS unsigned char* lds, const int G, const int c) {
    constexpr int QS = 264;
    LAS bf16_t* QT = (LAS bf16_t*)(lds);
    LAS bf16_t* KT = (LAS bf16_t*)(lds + 33792);
    LAS bf16_t* KD = (LAS bf16_t*)(lds + 67584);
    LAS float* TOT = (LAS float*)(lds + 129024);
    LAS float* AL = (LAS float*)(lds + 131072);
    const int tid = fresh_tid(), k = tid & 255, half = __builtin_amdgcn_readfirstlane(tid >> 8);
    const bf16_t* Qb = (const bf16_t*)(a.ws + WS_Q); const bf16_t* Kb = (const bf16_t*)(a.ws + WS_K); const bf16_t* ABb = (const bf16_t*)(a.ws + WS_AB);
    const int per = (5120 + G - 1) / G, t_lo = c * per, t_hi = (t_lo + per) < 5120 ? (t_lo + per) : 5120;
    if (t_lo >= t_hi) return;
    u32x4 pq[4], pk[4], pa = (u32x4){0u, 0u, 0u, 0u};
#define PRE_LOAD(tk) do { int chunk_, s_, L_, base_; pre_decode((tk), chunk_, s_, L_, base_); const int dir_ = s_ & 1, h_ = (s_ >> 1) & 3, c0_ = chunk_ * 64; \
        _Pragma("unroll") for (int i = 0; i < 4; ++i) { const int id = tid + 512 * i, j = id >> 5, ch = id & 31; const int tok = base_ + (dir_ ? (L_ - 1 - (c0_ + j)) : (c0_ + j)); const size_t ro = (size_t)tok * 1024 + h_ * 256 + ch * 8; pq[i] = *(const u32x4*)(Qb + ro); pk[i] = *(const u32x4*)(Kb + ro); } \
        if (tid < 128) { const int j = tid >> 1, ch = tid & 1; const int tok = base_ + (dir_ ? (L_ - 1 - (c0_ + j)) : (c0_ + j)); pa = *(const u32x4*)(ABb + (size_t)tok * 32 + dir_ * 16 + ch * 8); } } while (0)
    PRE_LOAD(t_lo);
    int cur_s = -1; float wv[16]; float bias = 0.f;
#pragma unroll
    for (int r = 0; r < 16; ++r) wv[r] = 0.f;
    for (int task = t_lo; task < t_hi; ++task) {
        int chunk, s, L, base; pre_decode(task, chunk, s, L, base);
        const int dir = s & 1, h = (s >> 1) & 3, c0 = chunk * 64;
        if (s != cur_s) { cur_s = s;
#pragma unroll
            for (int r = 0; r < 16; ++r) wv[r] = a.w_alpha[(dir * 16 + r) * 1024 + h * 256 + k];
            bias = a.b_alpha[dir * 1024 + h * 256 + k]; }
#pragma unroll
        for (int i = 0; i < 4; ++i) { const int id = tid + 512 * i, j = id >> 5, ch = id & 31; *(LAS u32x4*)(QT + j * QS + ch * 8) = pq[i]; *(LAS u32x4*)(KT + j * QS + ch * 8) = pk[i]; }
        if (tid < 128) { const int j = tid >> 1, ch = tid & 1; LAS float* ap = AL + j * 16 + ch * 8;
            *(LAS f32x4*)ap = (f32x4){bflo(pa.x), bfhi(pa.x), bflo(pa.y), bfhi(pa.y)}; *(LAS f32x4*)(ap + 4) = (f32x4){bflo(pa.z), bfhi(pa.z), bflo(pa.w), bfhi(pa.w)}; }
        { const int nx = task + 1 < t_hi ? task + 1 : task; PRE_LOAD(nx); }
        __syncthreads();
        float bc[32]; float cum = 0.f;
#pragma unroll
        for (int jj = 0; jj < 32; ++jj) { const int j = half * 32 + jj;
            const f32x4 a0 = *(const LAS f32x4*)(AL + j * 16), a1 = *(const LAS f32x4*)(AL + j * 16 + 4), a2 = *(const LAS f32x4*)(AL + j * 16 + 8), a3 = *(const LAS f32x4*)(AL + j * 16 + 12);
            float pre = bias;
#pragma unroll
            for (int r = 0; r < 4; ++r) pre += a0[r] * wv[r] + a1[r] * wv[4 + r] + a2[r] * wv[8 + r] + a3[r] * wv[12 + r];
            const float ls = fminf(pre, 0.f) - __logf(1.0f + __expf(-fabsf(pre)));
            cum += ls * 0.0625f; bc[jj] = cum; }
        TOT[half * 256 + k] = cum;
        __syncthreads();
        const float t0 = TOT[k], t1 = TOT[256 + k]; const float off = half ? t0 : 0.f; const float bl = t0 + t1;
        if (half == 0) ((float*)(a.ws + WS_DECG))[((size_t)dir * (T / 64) + ((base + c0) >> 6)) * 1024 + h * 256 + k] = __expf(bl);
#pragma unroll
        for (int jj = 0; jj < 32; ++jj) { const int j = half * 32 + jj; const float qv = bf2f(QT[j * QS + k]), kv = bf2f(KT[j * QS + k]); const float bb = bc[jj] + off;
            QT[j * QS + k] = f2bf(qv * __expf(bb) * 0.0625f); KT[j * QS + k] = f2bf(kv * __expf(-bb)); KD[j * QS + k] = f2bf(kv * __expf(bl - bb)); }
        __syncthreads();
        {   bf16_t* qg = (bf16_t*)(a.ws + WS_QTG) + (size_t)dir * T * 1024; bf16_t* kg = (bf16_t*)(a.ws + WS_KTG) + (size_t)dir * T * 1024; bf16_t* dg = (bf16_t*)(a.ws + WS_KDG) + (size_t)dir * T * 1024;
#pragma unroll
            for (int i = 0; i < 4; ++i) { const int id = tid + 512 * i, j = id >> 5, ch = id & 31; const size_t ro = (size_t)(base + c0 + j) * 1024 + h * 256 + ch * 8;
                *(u32x4*)(qg + ro) = *(const LAS u32x4*)(QT + j * QS + ch * 8); *(u32x4*)(kg + ro) = *(const LAS u32x4*)(KT + j * QS + ch * 8); *(u32x4*)(dg + ro) = *(const LAS u32x4*)(KD + j * QS + ch * 8); } }
        __syncthreads();
    }
#undef PRE_LOAD
}
typedef short s16x4 __attribute__((ext_vector_type(4)));
__device__ __forceinline__ bf16x8 tr_read8(const LAS bf16_t* p0, const int stride_el) {
    const s16x4 lo = __builtin_amdgcn_ds_read_tr16_b64_v4i16((LAS s16x4*)p0), hi = __builtin_amdgcn_ds_read_tr16_b64_v4i16((LAS s16x4*)(p0 + 4 * stride_el));
    return __builtin_shufflevector(lo, hi, 0, 1, 2, 3, 4, 5, 6, 7); }
__device__ __forceinline__ void phase_gla(const Args& a, LAS unsigned char* lds, const int G, const int c) {
    constexpr int QS = 264, VS = 136, KS = 72;
    LAS bf16_t* QT = (LAS bf16_t*)(lds);
    LAS bf16_t* KT = (LAS bf16_t*)(lds + 33792);
    LAS bf16_t* KD = (LAS bf16_t*)(lds + 67584);
    LAS bf16_t* VR = (LAS bf16_t*)(lds + 101376);
    LAS bf16_t* ATT = (LAS bf16_t*)(lds + 118784);
    LAS float* DEC = (LAS float*)(lds + 128000);
    const int tid = fresh_tid(), w = __builtin_amdgcn_readfirstlane(tid >> 6), lane = tid & 63, n = lane & 15, q = lane >> 4;
    const int trq = (lane & 15) >> 2, trp = lane & 3;
    const bf16_t* Vb = (const bf16_t*)(a.ws + WS_V);
    for (int u = c; u < 256 + 1024; u += G) {
        const bool lat = u < 256; const int uu = lat ? u : u - 256;
        const int sl = (uu & 7) * 8 + (((uu & 255) >> 3) >> 2), vs = ((uu & 255) >> 3) & 3, s = (uu >> 8) * 64 + sl;
        const int dir = s & 1, h = (s >> 1) & 3, b = s >> 3;
        const int L = lat ? 4096 : 256, base = lat ? TC + b * 4096 : b * 256, nsteps = L >> 6;
        f32x4 S[16];
        if (lat) { const float* sp = (dir ? a.st_b : a.st_f) + ((size_t)(b * 4 + h) * 256) * 512 + vs * 128 + w * 16 + n;
#pragma unroll
            for (int t = 0; t < 16; ++t)
#pragma unroll
                for (int r = 0; r < 4; ++r) S[t][r] = sp[(size_t)(t * 16 + 4 * q + r) * 512]; }
        else {
#pragma unroll
            for (int t = 0; t < 16; ++t) S[t] = (f32x4){0.f, 0.f, 0.f, 0.f}; }
        bf16_t* OX = (bf16_t*)(a.ws + (dir ? WS_OB : WS_OF));
        const bf16_t* qg = (const bf16_t*)(a.ws + WS_QTG) + (size_t)dir * T * 1024 + h * 256; const bf16_t* kg = (const bf16_t*)(a.ws + WS_KTG) + (size_t)dir * T * 1024 + h * 256; const bf16_t* dg = (const bf16_t*)(a.ws + WS_KDG) + (size_t)dir * T * 1024 + h * 256;
        const float* decg = (const float*)(a.ws + WS_DECG) + (size_t)dir * (T / 64) * 1024 + h * 256;
#define TOKC(cj) (base + (dir ? (L - 1 - (cj)) : (cj)))
        u32x4 pq[4], pk[4], pd[4], pv[2], pe;
#define GLA_LOAD(stp) do { const int cc0 = (stp) * 64; \
            _Pragma("unroll") for (int i = 0; i < 4; ++i) { const int id = tid + 512 * i, j = id >> 5, ch = id & 31; const size_t ro = (size_t)(base + cc0 + j) * 1024 + ch * 8; pq[i] = *(const u32x4*)(qg + ro); pk[i] = *(const u32x4*)(kg + ro); pd[i] = *(const u32x4*)(dg + ro); } \
            _Pragma("unroll") for (int i = 0; i < 2; ++i) { const int id = tid + 512 * i, j = id >> 4, ch = id & 15; pv[i] = *(const u32x4*)(Vb + (size_t)TOKC(cc0 + j) * 2048 + h * 512 + vs * 128 + ch * 8); } \
            if (tid < 64) pe = *(const u32x4*)(decg + (size_t)((base + cc0) >> 6) * 1024 + tid * 4); } while (0)
        pe = (u32x4){0u, 0u, 0u, 0u};
        GLA_LOAD(0);
        for (int step = 0; step < nsteps; ++step) {
            const int c0 = step * 64;
#pragma unroll
            for (int i = 0; i < 4; ++i) { const int id = tid + 512 * i, j = id >> 5, ch = id & 31; *(LAS u32x4*)(QT + j * QS + ch * 8) = pq[i]; *(LAS u32x4*)(KT + j * QS + ch * 8) = pk[i]; *(LAS u32x4*)(KD + j * QS + ch * 8) = pd[i]; }
#pragma unroll
            for (int i = 0; i < 2; ++i) { const int id = tid + 512 * i, j = id >> 4, ch = id & 15; *(LAS u32x4*)(VR + j * VS + ch * 8) = pv[i]; }
            if (tid < 64) *(LAS u32x4*)(DEC + tid * 4) = pe;
            { const int ns = step + 1 < nsteps ? step + 1 : step; GLA_LOAD(ns); }
            __syncthreads();
#pragma unroll
            for (int tt = 0; tt < 2; ++tt) { const int id = w * 2 + tt, jt = id >> 2, it = id & 3; f32x4 acc = (f32x4){0.f, 0.f, 0.f, 0.f};
                if (jt <= it) {
#pragma unroll
                    for (int ks = 0; ks < 8; ++ks) { const bf16x8 A = *(const LAS bf16x8*)(KT + (jt * 16 + n) * QS + ks * 32 + 8 * q); const bf16x8 B = *(const LAS bf16x8*)(QT + (it * 16 + n) * QS + ks * 32 + 8 * q); acc = mfma16(A, B, acc); }
#pragma unroll
                    for (int r = 0; r < 4; ++r) if (jt * 16 + 4 * q + r > it * 16 + n) acc[r] = 0.f; }
                u32x2 pk2; pk2.x = cvt_pk_bf16(acc[0], acc[1]); pk2.y = cvt_pk_bf16(acc[2], acc[3]);
                *(LAS u32x2*)(ATT + (it * 16 + n) * KS + jt * 16 + 4 * q) = pk2; }
            f32x4 o[4];
#pragma unroll
            for (int mt = 0; mt < 4; ++mt) o[mt] = (f32x4){0.f, 0.f, 0.f, 0.f};
#pragma unroll
            for (int kb = 0; kb < 8; ++kb) { u32x4 bs; bs.x = cvt_pk_bf16(S[2 * kb][0], S[2 * kb][1]); bs.y = cvt_pk_bf16(S[2 * kb][2], S[2 * kb][3]); bs.z = cvt_pk_bf16(S[2 * kb + 1][0], S[2 * kb + 1][1]); bs.w = cvt_pk_bf16(S[2 * kb + 1][2], S[2 * kb + 1][3]);
                const bf16x8 Bs = __builtin_bit_cast(bf16x8, bs);
#pragma unroll
                for (int mt = 0; mt < 4; ++mt) { const u32x2 lo = *(const LAS u32x2*)(QT + (mt * 16 + n) * QS + kb * 32 + 4 * q), hi = *(const LAS u32x2*)(QT + (mt * 16 + n) * QS + kb * 32 + 16 + 4 * q);
                    u32x4 av; av.x = lo.x; av.y = lo.y; av.z = hi.x; av.w = hi.y; o[mt] = mfma16(__builtin_bit_cast(bf16x8, av), Bs, o[mt]); } }
            __syncthreads();
            bf16x8 Bv[2];
#pragma unroll
            for (int js = 0; js < 2; ++js) Bv[js] = tr_read8(VR + (js * 32 + 8 * q + trq) * VS + w * 16 + 4 * trp, VS);
#pragma unroll
            for (int mt = 0; mt < 4; ++mt)
#pragma unroll
                for (int js = 0; js < 2; ++js) { const bf16x8 A = *(const LAS bf16x8*)(ATT + (mt * 16 + n) * KS + js * 32 + 8 * q); o[mt] = mfma16(A, Bv[js], o[mt]); }
#pragma unroll
            for (int mt = 0; mt < 4; ++mt)
#pragma unroll
                for (int r = 0; r < 4; ++r) OX[(size_t)TOKC(c0 + mt * 16 + 4 * q + r) * 2048 + h * 512 + vs * 128 + w * 16 + n] = f2bf(o[mt][r]);
#pragma unroll
            for (int t = 0; t < 16; ++t) { const f32x4 dc = *(const LAS f32x4*)(DEC + t * 16 + 4 * q); S[t] = S[t] * dc;
#pragma unroll
                for (int js = 0; js < 2; ++js) { const bf16x8 A = tr_read8(KD + (js * 32 + 8 * q + trq) * QS + t * 16 + 4 * trp, QS); S[t] = mfma16(A, Bv[js], S[t]); } }
            __syncthreads();
        }
#undef GLA_LOAD
#undef TOKC
        if (!lat) { float* sp = a.out + (size_t)167772160 + (dir ? (size_t)16777216 : (size_t)0) + ((size_t)(b * 4 + h) * 256) * 512 + vs * 128 + w * 16 + n;
#pragma unroll
            for (int t = 0; t < 16; ++t)
#pragma unroll
                for (int r = 0; r < 4; ++r) sp[(size_t)(t * 16 + 4 * q + r) * 512] = S[t][r]; }
    }
}

#ifndef PH_LO
#define PH_LO 0
#endif
#ifndef PH_HI
#define PH_HI 10
#endif
__global__ __launch_bounds__(512, 2) void mega(Args a) {
    extern __shared__ __attribute__((aligned(16))) unsigned char shm[];
    LAS unsigned char* lds = (LAS unsigned char*)shm;
    const int tid = fresh_tid(), G = gridDim.x, c = blockIdx.x;
    volatile LAS unsigned* st = (volatile LAS unsigned*)(lds + LDS_BARW);
    if (tid < 4) st[tid] = 0u;
    __syncthreads();
    XcdBarrier bar = xcd_barrier_post((unsigned*)(a.ws + WS_CTL), st);
    unsigned char* ws = a.ws;
    phase0(a, lds, G, c);
    xcd_barrier(bar);
    phase_h(a, G, c);
    xcd_barrier(bar);
    {
        BOrder S; S.nM = 160; S.nN = 41; S.nB = 1; S.nB2 = 1; S.G = G; S.c = c; S.nsplit = S.nN; S.aN = 0; S.bM = 0; S.A = (const char*)(ws + WS_H); S.B = (const char*)(ws + WS_WINT); S.sA1 = S.sA2 = S.sB1 = S.sB2 = 0; S.tA = (size_t)256 * 4096 * 2; S.tB = (size_t)256 * 4096 * 2;
        EpiB<DstInProj, false> E; E.f.ws = ws; pg8::gemm_phase(lds, 4096, 4096, 4096, S, E);
#if defined(PROBE_DUP_INPROJ)
        __syncthreads(); pg8::gemm_phase(lds, 4096, 4096, 4096, S, E);
#endif
    }
    xcd_barrier(bar);
    {
        BOrder S; S.nM = 4; S.nN = 160; S.nB = 4; S.nB2 = 1; S.G = G; S.c = c; S.nsplit = S.nN; S.aN = 0; S.bM = 0; S.A = (const char*)(ws + WS_DCH); S.B = (const char*)(ws + WS_FIN); S.sA1 = 0; S.sA2 = 0; S.sB1 = 1024; S.sB2 = 0; S.tA = (size_t)256 * 512 * 2; S.tB = (size_t)256 * 2048 * 2;
        EpiB<DstChDft, false> E; E.f.ws = ws; pg8::gemm_phase(lds, 512, 2048, 512, S, E); }
    xcd_barrier(bar);
    {
        BOrder S; S.nM = 1; S.nN = 2; S.nB = 128; S.nB2 = 4; S.G = G; S.c = c; S.nsplit = S.nN; S.aN = 0; S.bM = 0; S.A = (const char*)(ws + WS_PCTX); S.B = (const char*)(ws + WS_ZTC); S.sA1 = 0; S.sA2 = 0; S.sB1 = 1024; S.sB2 = (size_t)512 * 16384 * 2; S.tA = (size_t)256 * 512 * 2; S.tB = (size_t)256 * 16384 * 2;
        EpiB<DstPosCtx, false> E; E.f.ws = ws; pg8::gemm_phase(lds, 512, 16384, 512, S, E); }
    {
        BOrder S; S.nM = 64; S.nN = 32; S.nB = 1; S.nB2 = 1; S.G = G; S.c = c; S.nsplit = 4; S.aN = 2048; S.bM = 0; S.A = (const char*)(ws + WS_ZTL); S.B = (const char*)(ws + WS_PLAT); S.sA1 = S.sA2 = S.sB1 = S.sB2 = 0; S.tA = (size_t)256 * 8192 * 2; S.tB = (size_t)256 * 1024 * 2;
        EpiB<DstLatA, false> E; E.f.ws = ws; pg8::gemm_phase(lds, 8192, 1024, 1024, S, E); }
    xcd_barrier(bar);
    {
        BOrder S; S.nM = 16; S.nN = 2; S.nB = 32; S.nB2 = 4; S.G = G; S.c = c; S.nsplit = 2; S.aN = 0; S.bM = 1024; S.A = (const char*)(ws + WS_PLAT + (size_t)1024 * 1024 * 2); S.B = (const char*)(ws + WS_OF); S.sA1 = 0; S.sA2 = 0; S.sB1 = 16384; S.sB2 = (size_t)512 * 65536 * 2; S.tA = 0; S.tB = (size_t)256 * 65536 * 2;
        EpiB<DstLatB, false> E; E.f.ws = ws; pg8::gemm_phase(lds, 512, 65536, 512, S, E); }
    xcd_barrier(bar);
    {
        BOrder S; S.nM = 160; S.nN = 2; S.nB = 4; S.nB2 = 1; S.G = G; S.c = c; S.nsplit = S.nN; S.aN = 0; S.bM = 0; S.A = (const char*)(ws + WS_RE); S.B = (const char*)(ws + WS_WFT); S.sA1 = 1024; S.sA2 = 0; S.sB1 = (size_t)512 * 512 * 2; S.sB2 = 0; S.tA = (size_t)256 * 2048 * 2; S.tB = (size_t)256 * 512 * 2;
        EpiB<DstWf, true> E; E.f.ws = ws; pg8::gemm_phase(lds, 2048, 512, 512, S, E); }
    xcd_barrier(bar);
    phase_gla_pre(a, lds, G, c);
#if defined(PROBE_DUP_PRE)
    __syncthreads(); phase_gla_pre(a, lds, G, c);
#endif
    xcd_barrier(bar);
    phase_gla(a, lds, G, c);
#if defined(PROBE_DUP_GLA)
    __syncthreads(); phase_gla(a, lds, G, c);
#endif
    xcd_barrier(bar);
    phase_glapost(a, G, c);
    xcd_barrier(bar);
    {
        BOrder S; S.nM = 160; S.nN = 16; S.nB = 1; S.nB2 = 1; S.G = G; S.c = c; S.nsplit = S.nN; S.aN = 0; S.bM = 0; S.A = (const char*)(ws + WS_MIX); S.B = (const char*)(ws + WS_WOUTT); S.sA1 = S.sA2 = S.sB1 = S.sB2 = 0; S.tA = (size_t)256 * 4096 * 2; S.tB = (size_t)256 * 4096 * 2;
        EpiB<DstOut, false> E; E.f.ws = ws; pg8::gemm_phase(lds, 4096, 4096, 4096, S, E); }
    xcd_barrier(bar);
    phase_final(a, G, c);
}

extern "C" void kernel_launch(void* const* d_in, const int* in_sizes, int n_in, void* d_out, int out_size, void* d_ws, size_t ws_size, hipStream_t stream) {
    static int grid = 0;
    if (grid == 0) {
        int dev = 0, cus = 0, per_cu = 0;
        if (n_in != 16 || ws_size < WS_END) { grid = -1; return; }
        if (hipGetDevice(&dev) != hipSuccess || hipDeviceGetAttribute(&cus, hipDeviceAttributeMultiprocessorCount, dev) != hipSuccess) { grid = -1; return; }
        if (hipFuncSetAttribute((const void*)mega, hipFuncAttributeMaxDynamicSharedMemorySize, LDS_BYTES) != hipSuccess) { grid = -1; return; }
        if (hipOccupancyMaxActiveBlocksPerMultiprocessor(&per_cu, (const void*)mega, 512, LDS_BYTES) != hipSuccess || per_cu < 1) { (void)hipGetLastError(); per_cu = 1; }
        grid = cus;
        if (grid > 256) grid = 256;
    }
    if (grid < 0) return;
    (void)hipMemsetAsync((char*)d_ws + WS_CTL, 0, WS_ZERO_BYTES, stream);
    Args a{};
    a.x_prompt = (const float*)d_in[0]; a.x_sample = (const float*)d_in[1]; a.st_f = (const float*)d_in[2]; a.st_b = (const float*)d_in[3]; a.c = (const float*)d_in[4]; a.c_ctx = (const float*)d_in[5];
    a.ada_w = (const float*)d_in[6]; a.ada_b = (const float*)d_in[7]; a.norm_w = (const float*)d_in[8]; a.w_in = (const float*)d_in[9]; a.w_alpha = (const float*)d_in[10]; a.b_alpha = (const float*)d_in[11];
    a.w_fourier = (const float*)d_in[12]; a.gla_norm_w = (const float*)d_in[13]; a.w_out = (const float*)d_in[14]; a.final_norm_w = (const float*)d_in[15];
    a.out = (float*)d_out; a.ws = (unsigned char*)d_ws;
    hipLaunchKernelGGL(mega, dim3(grid), dim3(512), LDS_BYTES, stream, a);
}
```

```cpp
#include <hip/hip_runtime.h>
#include <stdint.h>
#define LAS __attribute__((address_space(3)))
typedef unsigned short bf16_t;
typedef short bf16x8 __attribute__((ext_vector_type(8)));
typedef short bf16x4 __attribute__((ext_vector_type(4)));
typedef float f32x4 __attribute__((ext_vector_type(4)));
typedef float f32x2 __attribute__((ext_vector_type(2)));
typedef unsigned u32x4 __attribute__((ext_vector_type(4)));
typedef unsigned u32x2 __attribute__((ext_vector_type(2)));

constexpr int D = 4096, TC = 8192, TL = 32768, T = TC + TL, NIN = 10272, NINP = 10496;
constexpr int LDS_BYTES = 147456;
constexpr int LDS_BARW = 147456 - 16;
constexpr size_t WS_CTL = 0;
constexpr size_t WS_MODV = 16384;
constexpr size_t WS_ZERO_BYTES = 16384 + 9 * 12288 * 4;
constexpr size_t WS_H = 1u << 20;
constexpr size_t SZ_H = (size_t)T * 4096 * 2;
constexpr size_t WS_ZTC = WS_H;
constexpr size_t WS_ZTL = WS_H + (size_t)4 * 512 * 16384 * 2;
constexpr size_t WS_MIX = WS_H;
constexpr size_t WS_WINT = WS_H + SZ_H;
constexpr size_t WS_WOUTT = WS_WINT + (size_t)NINP * 4096 * 2;
constexpr size_t WS_WFT = WS_WOUTT + (size_t)4096 * 4096 * 2;
constexpr size_t WS_DCH = WS_WFT + (size_t)4 * 512 * 512 * 2;
constexpr size_t WS_PCTX = WS_DCH + (size_t)1024 * 512 * 2;
constexpr size_t WS_PLAT = WS_PCTX + (size_t)256 * 512 * 2;
constexpr size_t WS_FIN = WS_PLAT + (size_t)4096 * 8192 * 2;
constexpr size_t WS_RE = WS_FIN;
constexpr size_t WS_FGATE = WS_FIN + (size_t)T * 2048 * 2;
constexpr size_t WS_Q = WS_FGATE + (size_t)T * 2048 * 2;
constexpr size_t WS_K = WS_Q + (size_t)T * 1024 * 2;
constexpr size_t WS_V = WS_K + (size_t)T * 1024 * 2;
constexpr size_t WS_GG = WS_V + (size_t)T * 2048 * 2;
constexpr size_t WS_AB = WS_GG + (size_t)T * 2048 * 2;
constexpr size_t WS_OF = WS_AB + (size_t)T * 32 * 2;
constexpr size_t WS_OB = WS_OF + (size_t)T * 2048 * 2;
constexpr size_t WS_KDG = WS_OB + (size_t)T * 2048 * 2;
constexpr size_t WS_DECG = WS_KDG + (size_t)2 * T * 1024 * 2;
constexpr size_t WS_QTG = WS_FIN;
constexpr size_t WS_KTG = WS_FGATE;
constexpr size_t WS_END = WS_DECG + (size_t)2 * (T / 64) * 1024 * 4;

struct Args {
    const float* x_prompt; const float* x_sample; const float* st_f; const float* st_b; const float* c; const float* c_ctx;
    const float* ada_w; const float* ada_b; const float* norm_w; const float* w_in; const float* w_alpha; const float* b_alpha;
    const float* w_fourier; const float* gla_norm_w; const float* w_out; const float* final_norm_w;
    float* out; unsigned char* ws;
};

__device__ __forceinline__ unsigned cvt_pk_bf16(float lo, float hi) { unsigned r; asm volatile("v_cvt_pk_bf16_f32 %0, %1, %2" : "=v"(r) : "v"(lo), "v"(hi)); return r; }
__device__ __forceinline__ float bf2f(unsigned short b) { return __uint_as_float(((unsigned)b) << 16); }
__device__ __forceinline__ float bflo(unsigned w) { return __uint_as_float(w << 16); }
__device__ __forceinline__ float bfhi(unsigned w) { return __uint_as_float(w & 0xffff0000u); }
__device__ __forceinline__ float silu_f(float x) { return x / (1.0f + __expf(-x)); }
__device__ __forceinline__ float wave_sum(float v) {
#pragma unroll
    for (int o = 32; o >= 1; o >>= 1) v += __shfl_xor(v, o);
    return v; }

__device__ __forceinline__ int fresh_tid() { int t = threadIdx.x; asm volatile("" : "+v"(t)); return t; }
#define XB_TMO      128
#define XB_XCNT(j)  (256  + 64 * (j))
#define XB_XSUB(j)  (1280 + 64 * (j))
#define XB_XGEN(j)  (2304 + 64 * (j))
#define XB_TOP      3328
#define XB_TOPGEN   3392
#define XCD_BAR_WORDS 3456
#define XB_SPIN_CAP (1u << 18)
#define LAS __attribute__((address_space(3)))

__device__ __forceinline__ unsigned xb_ld(unsigned* p)              { return __hip_atomic_load(p, __ATOMIC_RELAXED, __HIP_MEMORY_SCOPE_AGENT); }
__device__ __forceinline__ unsigned xb_add(unsigned* p, unsigned v) { return __hip_atomic_fetch_add(p, v, __ATOMIC_RELAXED, __HIP_MEMORY_SCOPE_AGENT); }
__device__ __forceinline__ unsigned xb_xcc_id() { return (unsigned)__builtin_amdgcn_s_getreg((3 << 11) | 20) & 0xFu; }
#define XB_SPIN(cond, bar) do { unsigned _sp = 0; while (cond) { __builtin_amdgcn_s_sleep(1); \
    if ((++_sp & 255u) == 0u) { if (xb_ld(&(bar)[XB_TMO])) break; if (_sp > XB_SPIN_CAP) { atomicAdd(&(bar)[XB_TMO], 1u); break; } } } } while (0)

struct XcdBarrier {
    unsigned* bar; unsigned x;
    volatile LAS unsigned* st;
};

__device__ __forceinline__ XcdBarrier xcd_barrier_post(unsigned* bar, volatile LAS unsigned* st) {
    XcdBarrier b; b.bar = bar; b.x = xb_xcc_id(); b.st = st;
    if (threadIdx.x == 0) (void)xb_add(&bar[XB_XCNT(b.x)], 1u);
    return b;
}
__device__ __forceinline__ void xcd_barrier_complete(unsigned* bar, unsigned x, unsigned& nloc, unsigned& nx) {
    const unsigned G = gridDim.x * gridDim.y * gridDim.z;
    unsigned sum, cnt, mine, sp = 0u;
    for (;;) {
        sum = 0u; cnt = 0u; mine = 0u;
#pragma unroll
        for (unsigned j = 0; j < 16; ++j) { const unsigned c = xb_ld(&bar[XB_XCNT(j)]); sum += c; cnt += (c > 0u) ? 1u : 0u; mine = (j == x) ? c : mine; }
        if (sum == G) break;
        __builtin_amdgcn_s_sleep(1);
        if ((++sp & 255u) == 0u) { if (xb_ld(&bar[XB_TMO])) break; if (sp > XB_SPIN_CAP) { atomicAdd(&bar[XB_TMO], 1u); break; } }
    }
    nloc = mine > 0u ? mine : 1u; nx = cnt > 0u ? cnt : 1u;
}

__device__ __forceinline__ void xcd_barrier(const XcdBarrier& b) {
    asm volatile("s_waitcnt vmcnt(0)" ::: "memory");
    __syncthreads();
    if (threadIdx.x == 0) {
        unsigned* bar = b.bar;
        __builtin_amdgcn_s_waitcnt(0);
        unsigned nloc = b.st[0], nx = b.st[1];
        if (nloc == 0u) { xcd_barrier_complete(bar, b.x, nloc, nx); b.st[0] = nloc; b.st[1] = nx; }
        const unsigned old = xb_add(&bar[XB_XSUB(b.x)], 1u);
        const unsigned gen = old / nloc;
        if (old + 1u == (gen + 1u) * nloc) {
            __builtin_amdgcn_fence(__ATOMIC_RELEASE, "agent");
            asm volatile("s_waitcnt vmcnt(0)" ::: "memory");
            const unsigned og = xb_add(&bar[XB_TOP], 1u);
            const unsigned tg = og / nx;
            if (og + 1u == (tg + 1u) * nx) xb_add(&bar[XB_TOPGEN], 1u);
            else XB_SPIN(xb_ld(&bar[XB_TOPGEN]) == tg, bar);
            __builtin_amdgcn_fence(__ATOMIC_ACQUIRE, "agent");
            xb_add(&bar[XB_XGEN(b.x)], 1u);
            asm volatile("s_waitcnt vmcnt(0)" ::: "memory");
        } else {
            XB_SPIN(xb_ld(&bar[XB_XGEN(b.x)]) == gen, bar);
            __builtin_amdgcn_fence(__ATOMIC_ACQUIRE, "agent");
            asm volatile("s_waitcnt vmcnt(0)" ::: "memory");
        }
    }
    __syncthreads();
}

namespace pg8 {
#define PG8_LAS __attribute__((address_space(3)))
constexpr int BM = 256, BK = 64, HALF = 128, HTB = HALF * BK * 2, STAGE_BYTES = 8 * HTB, NXCD = 8, WGM = 4;
__host__ __device__ __forceinline__ int lds_byte(int r, int c) { const int st = (r >> 4) * 2 + (c >> 5), rr = r & 15, cc = c & 31, ob = rr * 64 + cc * 2; return st * 1024 + (ob ^ (((ob >> 9) & 1) << 5)); }
__host__ __device__ __forceinline__ void stage_rc(int b, int& R, int& C) { const int st = b / 1024, sb = b % 1024, swz = sb ^ (((sb >> 9) & 1) << 5); R = (st >> 1) * 16 + swz / 64; C = (st & 1) * 32 + (swz % 64) / 2; }
__host__ __device__ __forceinline__ int perm32(int rho) { const int n = rho >> 4, i = rho & 15; return 8 * (i >> 2) + 4 * n + (i & 3); }
struct Unit { const char* a; const char* b; int pm, pn, bz; };
struct BOrder {
    int nM, nN, nB, nB2, G, c, nsplit; const char* A; const char* B; size_t sA1, sA2, sB1, sB2, tA, tB, aN, bM;
    __device__ __forceinline__ bool next(int i, Unit& u) const {
        const long L = (long)i * G + c; const int nwg = nB * nM * nN; if (L >= nwg) return false;
        int wgid = (int)L; { const int q = nwg / NXCD, r = nwg % NXCD, xcd = wgid % NXCD, off = wgid / NXCD; wgid = (xcd < r ? xcd * (q + 1) : r * (q + 1) + (xcd - r) * q) + off; }
        const int per = nM * nN, bz = wgid / per; wgid -= bz * per;
        const int nig = WGM * nN, gid = wgid / nig, fm = gid * WGM, gsz = (nM - fm) < WGM ? (nM - fm) : WGM;
        u.pm = fm + ((wgid % nig) % gsz); u.pn = (wgid % nig) / gsz; u.bz = bz;
        const int b1 = bz / nB2, b2 = bz % nB2;
        u.a = A + (size_t)b1 * sA1 + (size_t)b2 * sA2 + (size_t)u.pm * tA + (size_t)(u.pn / nsplit) * aN; u.b = B + (size_t)b1 * sB1 + (size_t)b2 * sB2 + (size_t)(u.pn % nsplit) * tB + (size_t)u.pm * bM; return true;
    }
};
template <class Epi, class Sched>
__device__ __forceinline__ void gemm_phase(PG8_LAS unsigned char* lds, const int lda, const int ldb, const int K, const Sched& S, const Epi& E) {
    const int tid = fresh_tid(), wid = __builtin_amdgcn_readfirstlane(tid >> 6), lane = tid & 63, wr = wid >> 2, wc = wid & 3, fr = lane & 15, fq = lane >> 4;
    const int nt = K / BK;
    unsigned voffA[2], voffB[2];
#pragma unroll
    for (int i = 0; i < 2; ++i) { int R, C; stage_rc(tid * 16 + i * 8192, R, C); const int Rb = Epi::PERM ? ((R & ~31) + perm32(R & 31)) : R;
        voffA[i] = (unsigned)(R * lda + C) * 2u; voffB[i] = (unsigned)(Rb * ldb + C) * 2u; }
    const size_t kstep = (size_t)(BK * 2);
    const size_t hsA = (size_t)HALF * lda * 2, hsB = (size_t)HALF * ldb * 2;
    const unsigned ldsw = (unsigned)wid * 1024u;
    const int aoff = lds_byte(wr * 64 + fr, fq * 8), boff = lds_byte(wc * 32 + fr, fq * 8);
#define PG8_SA(b, h) (((b) * 2 + (h)) * HTB)
#define PG8_SB(b, h) ((4 + (b) * 2 + (h)) * HTB)
#define PG8_STAGE(bufoff, gbase, voff) do { _Pragma("unroll") for (int _i = 0; _i < 2; ++_i) \
        __builtin_amdgcn_global_load_lds((const unsigned*)((const char*)(gbase) + (voff)[_i]), (PG8_LAS unsigned*)(lds + (bufoff) + ldsw + _i * 8192), 16, 0, 0); } while (0)
#define PG8_LDA(dst, b, h) do { _Pragma("unroll") for (int m = 0; m < 4; ++m) _Pragma("unroll") for (int k = 0; k < 2; ++k) dst[m][k] = *(const PG8_LAS bf16x8*)(lds + PG8_SA(b, h) + aoff + m * 2048 + k * 1024); } while (0)
#define PG8_LDB(dst, b, h) do { _Pragma("unroll") for (int n = 0; n < 2; ++n) _Pragma("unroll") for (int k = 0; k < 2; ++k) dst[n][k] = *(const PG8_LAS bf16x8*)(lds + PG8_SB(b, h) + boff + n * 2048 + k * 1024); } while (0)
#define PG8_MMA(ai, bj, At, Bt) do { __builtin_amdgcn_s_setprio(1); _Pragma("unroll") for (int m = 0; m < 4; ++m) _Pragma("unroll") for (int n = 0; n < 2; ++n) _Pragma("unroll") for (int k = 0; k < 2; ++k) \
        acc[ai][bj][m][n] = __builtin_amdgcn_mfma_f32_16x16x32_bf16(Bt[n][k], At[m][k], acc[ai][bj][m][n], 0, 0, 0); __builtin_amdgcn_s_setprio(0); } while (0)
#define PG8_WAIT_V(n) asm volatile("s_waitcnt vmcnt(" #n ")" ::: "memory")
#define PG8_WAIT_L(n) asm volatile("s_waitcnt lgkmcnt(" #n ")" ::: "memory")
#define PG8_BAR __builtin_amdgcn_s_barrier()
#define PG8_SCHED __builtin_amdgcn_sched_barrier(0)
    Unit cur, nxt; int ui = 0;
    if (!S.next(0, cur)) return;
    f32x4 acc[2][2][4][2];
#pragma unroll
    for (int a = 0; a < 2; ++a)
#pragma unroll
        for (int b = 0; b < 2; ++b)
#pragma unroll
            for (int m = 0; m < 4; ++m)
#pragma unroll
                for (int n = 0; n < 2; ++n) acc[a][b][m][n] = (f32x4){0.f, 0.f, 0.f, 0.f};
    bf16x8 At[4][2], B0[2][2], B1[2][2];
    const char* cA = cur.a; const char* cB = cur.b;
    PG8_STAGE(PG8_SB(0, 0), cB, voffB); PG8_STAGE(PG8_SA(0, 0), cA, voffA); PG8_STAGE(PG8_SB(0, 1), cB + hsB, voffB); PG8_STAGE(PG8_SA(0, 1), cA + hsA, voffA);
    if (wr == 1) PG8_BAR;
    PG8_WAIT_V(4); PG8_BAR;
    PG8_STAGE(PG8_SB(1, 0), cB + kstep, voffB); PG8_STAGE(PG8_SA(1, 0), cA + kstep, voffA); PG8_STAGE(PG8_SB(1, 1), cB + hsB + kstep, voffB);
    PG8_WAIT_V(6); PG8_BAR;
    for (;;) {
        const bool has_next = S.next(ui + 1, nxt);
        const char* nA = has_next ? nxt.a : cA; const char* nB = has_next ? nxt.b : cB;
        for (int t = 0; t < nt; t += 2) {
            const bool last = (t == nt - 2);
            const char* a1 = cA + (size_t)(t + 1) * kstep;
            const char* a2 = last ? nA : cA + (size_t)(t + 2) * kstep; const char* b2 = last ? nB : cB + (size_t)(t + 2) * kstep;
            const char* a3 = a2 + kstep; const char* b3 = b2 + kstep;
            PG8_LDB(B0, 0, 0); PG8_SCHED; PG8_LDA(At, 0, 0); PG8_STAGE(PG8_SA(1, 1), a1 + hsA, voffA);
            PG8_WAIT_L(8); PG8_BAR; PG8_WAIT_L(0); PG8_MMA(0, 0, At, B0); PG8_BAR; PG8_SCHED;
            PG8_LDB(B1, 0, 1); PG8_STAGE(PG8_SB(0, 0), b2, voffB);
            PG8_BAR; PG8_WAIT_L(0); PG8_MMA(0, 1, At, B1); PG8_BAR;
            PG8_LDA(At, 0, 1); PG8_STAGE(PG8_SA(0, 0), a2, voffA);
            PG8_BAR; PG8_WAIT_L(0); PG8_MMA(1, 0, At, B0); PG8_BAR; PG8_SCHED;
            PG8_STAGE(PG8_SB(0, 1), b2 + hsB, voffB);
            PG8_WAIT_V(6); PG8_BAR; PG8_MMA(1, 1, At, B1); PG8_BAR;
            PG8_LDB(B0, 1, 0); PG8_SCHED; PG8_LDA(At, 1, 0); PG8_STAGE(PG8_SA(0, 1), a2 + hsA, voffA);
            PG8_WAIT_L(8); PG8_BAR; PG8_WAIT_L(0); PG8_MMA(0, 0, At, B0); PG8_BAR; PG8_SCHED;
            PG8_LDB(B1, 1, 1); PG8_STAGE(PG8_SB(1, 0), b3, voffB);
            PG8_BAR; PG8_WAIT_L(0); PG8_MMA(0, 1, At, B1); PG8_BAR;
            PG8_LDA(At, 1, 1); PG8_STAGE(PG8_SA(1, 0), a3, voffA);
            PG8_BAR; PG8_WAIT_L(0); PG8_MMA(1, 0, At, B0); PG8_BAR; PG8_SCHED;
            PG8_STAGE(PG8_SB(1, 1), b3 + hsB, voffB);
            PG8_WAIT_V(6); PG8_BAR; PG8_MMA(1, 1, At, B1); PG8_BAR;
        }
        E(acc, cur, wr, wc, fr, fq);
        if (!has_next) break;
#pragma unroll
        for (int a = 0; a < 2; ++a)
#pragma unroll
            for (int b = 0; b < 2; ++b)
#pragma unroll
                for (int m = 0; m < 4; ++m)
#pragma unroll
                    for (int n = 0; n < 2; ++n) acc[a][b][m][n] = (f32x4){0.f, 0.f, 0.f, 0.f};
        cur = nxt; cA = nA; cB = nB; ++ui;
    }
    PG8_WAIT_V(0);
    if (wr == 0) PG8_BAR;
    PG8_BAR;
#undef PG8_SA
#undef PG8_SB
#undef PG8_STAGE
#undef PG8_LDA
#undef PG8_LDB
#undef PG8_MMA
#undef PG8_WAIT_V
#undef PG8_WAIT_L
#undef PG8_BAR
#undef PG8_SCHED
}
}

using pg8::Unit; using pg8::BOrder;
struct TileDst { bf16_t* p; int ld; int ncols; const bf16_t* gate; int gld; int cmode, cpar, rmode, rpar; };
template <class F, bool GATE> struct EpiB {
    static constexpr bool PERM = true; F f;
    __device__ __forceinline__ void operator()(const f32x4 (&acc)[2][2][4][2], const Unit& u, int wr, int wc, int fr, int fq) const {
        const TileDst d = f(u);
        const int r0 = wr * 64 + fr, c0 = wc * 32 + 8 * fq;
#pragma unroll
        for (int ai = 0; ai < 2; ++ai)
#pragma unroll
            for (int m = 0; m < 4; ++m) { const int row = r0 + ai * 128 + m * 16; const int drow = d.rmode ? ((row & 63) * 64 + d.rpar + (row >> 6)) : row;
#pragma unroll
                for (int bj = 0; bj < 2; ++bj) { const int col = c0 + bj * 128; int dcol = col;
                    if (d.cmode == 1) dcol = (col >> 6) * 128 + (col & 63); else if (d.cmode == 2) { const int nn = d.cpar + col; dcol = (nn >> 4) * 128 + ((nn >> 3) & 1) * 64; }
                    if (col < d.ncols) {
                        f32x4 v0 = acc[ai][bj][m][0], v1 = acc[ai][bj][m][1];
                        if (GATE) { const u32x4 g = *(const u32x4*)(d.gate + (size_t)row * d.gld + col);
                            v0[0] *= silu_f(bflo(g.x)); v0[1] *= silu_f(bfhi(g.x)); v0[2] *= silu_f(bflo(g.y)); v0[3] *= silu_f(bfhi(g.y));
                            v1[0] *= silu_f(bflo(g.z)); v1[1] *= silu_f(bfhi(g.z)); v1[2] *= silu_f(bflo(g.w)); v1[3] *= silu_f(bfhi(g.w)); }
                        u32x4 w; w.x = cvt_pk_bf16(v0[0], v0[1]); w.y = cvt_pk_bf16(v0[2], v0[3]); w.z = cvt_pk_bf16(v1[0], v1[1]); w.w = cvt_pk_bf16(v1[2], v1[3]);
                        *(u32x4*)(d.p + (size_t)drow * d.ld + dcol) = w; } } }
    }
};
struct DstInProj { unsigned char* ws;
    __device__ __forceinline__ TileDst operator()(const Unit& u) const { const int pn = u.pn; size_t off; int ld, co, nc = 256;
        if (pn < 8) { off = WS_FIN; ld = 2048; co = pn * 256; } else if (pn < 16) { off = WS_FGATE; ld = 2048; co = (pn - 8) * 256; }
        else if (pn < 20) { off = WS_Q; ld = 1024; co = (pn - 16) * 256; } else if (pn < 24) { off = WS_K; ld = 1024; co = (pn - 20) * 256; }
        else if (pn < 32) { off = WS_V; ld = 2048; co = (pn - 24) * 256; } else if (pn < 40) { off = WS_GG; ld = 2048; co = (pn - 32) * 256; }
        else { off = WS_AB; ld = 32; co = 0; nc = 32; }
        TileDst d; d.cmode = 0; d.cpar = 0; d.rmode = 0; d.rpar = 0; d.p = (bf16_t*)(ws + off) + (size_t)u.pm * 256 * ld + co; d.ld = ld; d.ncols = nc; d.gate = nullptr; d.gld = 0; return d; } };
struct DstChDft { unsigned char* ws;
    __device__ __forceinline__ TileDst operator()(const Unit& u) const { const int g = u.bz, part = u.pm >> 1, cp0 = (u.pm & 1) * 256, pn = u.pn; TileDst d; d.cmode = 0; d.cpar = 0; d.rmode = 0; d.rpar = 0; d.ncols = 256; d.gate = nullptr; d.gld = 0;
        if (pn < 32) { d.ld = 16384; d.p = (bf16_t*)(ws + WS_ZTC) + (size_t)(g * 512 + cp0) * 16384 + pn * 512 + part * 256; }
        else { const int lt = (pn - 32) * 256, b = lt >> 12, l0 = lt & 4095; d.ld = 65536; d.cmode = 1; d.p = (bf16_t*)(ws + WS_ZTL) + (size_t)(g * 512 + cp0) * 65536 + b * 8192 + (l0 >> 6) * 128 + part * 64; }
        return d; } };
struct DstPosCtx { unsigned char* ws;
    __device__ __forceinline__ TileDst operator()(const Unit& u) const { const int b = u.bz >> 2, g = u.bz & 3; TileDst d; d.cmode = 0; d.cpar = 0; d.rmode = 0; d.rpar = 0; d.ncols = 256; d.gate = nullptr; d.gld = 0; d.ld = 2048;
        d.p = (bf16_t*)(ws + WS_RE) + (size_t)(b * 256) * 2048 + g * 512 + u.pn * 256; return d; } };
struct DstLatA { unsigned char* ws;
    __device__ __forceinline__ TileDst operator()(const Unit& u) const { TileDst d; d.cmode = 2; d.cpar = (u.pn & 3) * 256; d.rmode = 0; d.rpar = 0; d.ncols = 256; d.gate = nullptr; d.gld = 0; d.ld = 8192;
        d.p = (bf16_t*)(ws + WS_OF) + (size_t)(u.pm * 256) * 8192 + (u.pn >> 2) * 8; return d; } };
struct DstLatB { unsigned char* ws;
    __device__ __forceinline__ TileDst operator()(const Unit& u) const { const int b = u.bz >> 2, g = u.bz & 3; TileDst d; d.cmode = 0; d.cpar = 0; d.rmode = 1; d.rpar = u.pm * 4; d.ncols = 256; d.gate = nullptr; d.gld = 0; d.ld = 2048;
        d.p = (bf16_t*)(ws + WS_RE) + (size_t)(TC + b * 4096) * 2048 + g * 512 + u.pn * 256; return d; } };
struct DstWf { unsigned char* ws;
    __device__ __forceinline__ TileDst operator()(const Unit& u) const { const int g = u.bz; TileDst d; d.cmode = 0; d.cpar = 0; d.rmode = 0; d.rpar = 0; d.ncols = 256; d.ld = 4096; d.gld = 2048;
        d.p = (bf16_t*)(ws + WS_MIX) + (size_t)(u.pm * 256) * 4096 + g * 512 + u.pn * 256;
        d.gate = (const bf16_t*)(ws + WS_FGATE) + (size_t)(u.pm * 256) * 2048 + g * 512 + u.pn * 256; return d; } };
struct DstOut { unsigned char* ws;
    __device__ __forceinline__ TileDst operator()(const Unit& u) const { TileDst d; d.cmode = 0; d.cpar = 0; d.rmode = 0; d.rpar = 0; d.ncols = 256; d.gate = nullptr; d.gld = 0; d.ld = 4096;
        d.p = (bf16_t*)(ws + WS_OF) + (size_t)(u.pm * 256) * 4096 + u.pn * 256; return d; } };
struct EpiOut {
    static constexpr bool PERM = false; const float* xp; const float* xs; const float* modv; float* out;
    __device__ __forceinline__ void operator()(const f32x4 (&acc)[2][2][4][2], const Unit& u, int wr, int wc, int fr, int fq) const {
        const int t0 = u.pm * 256; const int bidx = t0 < TC ? 0 : 1 + ((t0 - TC) >> 12);
        const float* x = (t0 < TC ? xp + (size_t)t0 * 4096 : xs + (size_t)(t0 - TC) * 4096) + u.pn * 256;
        const float* gt = modv + bidx * 12288 + 8192 + u.pn * 256; float* o = out + (size_t)t0 * 4096 + u.pn * 256;
        const int r0 = wr * 64 + fr, c0 = wc * 32 + 4 * fq;
#pragma unroll
        for (int ai = 0; ai < 2; ++ai)
#pragma unroll
            for (int m = 0; m < 4; ++m) { const size_t ro = (size_t)(r0 + ai * 128 + m * 16) * 4096;
#pragma unroll
                for (int bj = 0; bj < 2; ++bj)
#pragma unroll
                    for (int n = 0; n < 2; ++n) { const int col = c0 + bj * 128 + n * 16; const f32x4 g = *(const f32x4*)(gt + col); const f32x4 xv = *(const f32x4*)(x + ro + col);
                        *(f32x4*)(o + ro + col) = xv + g * acc[ai][bj][m][n]; } }
    }
};

__device__ __forceinline__ void store_bf8(bf16_t* p, const float (&e)[8]) { u32x4 w; w.x = cvt_pk_bf16(e[0], e[1]); w.y = cvt_pk_bf16(e[2], e[3]); w.z = cvt_pk_bf16(e[4], e[5]); w.w = cvt_pk_bf16(e[6], e[7]); *(u32x4*)p = w; }
__device__ __forceinline__ void phase0(const Args& a, LAS unsigned char* lds, const int G, const int c) {
    const int tid = fresh_tid(), wid = tid >> 6, lane = tid & 63;
    float* modv = (float*)(a.ws + WS_MODV);
    {   LAS float* sv = (LAS float*)(lds + wid * 4608);
        for (int task = c * 8 + wid; task < 1536; task += G * 8) {
            const int cb = task % 48, ks = task / 48, k0 = ks * 128;
            for (int e = lane; e < 9 * 128; e += 64) { const int bi = e >> 7, kk = e & 127; const float x = bi == 0 ? a.c_ctx[k0 + kk] : a.c[(bi - 1) * 4096 + k0 + kk]; sv[e] = silu_f(x); }
            f32x4 acc[9];
#pragma unroll
            for (int bi = 0; bi < 9; ++bi) acc[bi] = (f32x4){0.f, 0.f, 0.f, 0.f};
            const float* wp = a.ada_w + (size_t)k0 * 12288 + cb * 256 + lane * 4;
#pragma unroll 8
            for (int kk = 0; kk < 128; ++kk) { const f32x4 w = *(const f32x4*)(wp + (size_t)kk * 12288);
#pragma unroll
                for (int bi = 0; bi < 9; ++bi) acc[bi] += sv[bi * 128 + kk] * w; }
            const int col = cb * 256 + lane * 4;
#pragma unroll
            for (int bi = 0; bi < 9; ++bi)
#pragma unroll
                for (int e = 0; e < 4; ++e) { const float v = acc[bi][e] + (ks == 0 ? a.ada_b[col + e] : 0.f); atomicAdd(modv + bi * 12288 + col + e, v); }
        }
    }
    __syncthreads();
    {   LAS float* tile = (LAS float*)(lds + 40960);
        for (int tt = c; tt < 2624 + 1024 + 64; tt += G) {
            const float* src; bf16_t* dst; int N, Kd, kt, ng;
            if (tt < 2624) { kt = tt / 41; ng = tt % 41; src = a.w_in; N = NIN; Kd = 4096; dst = (bf16_t*)(a.ws + WS_WINT); }
            else if (tt < 3648) { const int t2 = tt - 2624; kt = t2 >> 4; ng = t2 & 15; src = a.w_out; N = 4096; Kd = 4096; dst = (bf16_t*)(a.ws + WS_WOUTT); }
            else { const int t2 = tt - 3648, g = t2 >> 4, r = t2 & 15; kt = r >> 1; ng = r & 1; src = a.w_fourier + (size_t)g * 512 * 512; N = 512; Kd = 512; dst = (bf16_t*)(a.ws + WS_WFT) + (size_t)g * 512 * 512; }
            const int k0 = kt * 64, n0 = ng * 256;
            {   const int r = tid >> 4, c4 = (tid & 15) * 4; f32x4 v[4][2];
#pragma unroll
                for (int sub = 0; sub < 4; ++sub)
#pragma unroll
                    for (int rr = 0; rr < 2; ++rr) { v[sub][rr] = (f32x4){0.f, 0.f, 0.f, 0.f}; if (n0 + sub * 64 + c4 < N) v[sub][rr] = *(const f32x4*)(src + (size_t)(k0 + r + rr * 32) * N + n0 + sub * 64 + c4); }
#pragma unroll
                for (int sub = 0; sub < 4; ++sub)
#pragma unroll
                    for (int rr = 0; rr < 2; ++rr) { LAS float* tp = tile + sub * 4160 + (r + rr * 32) * 65 + c4; tp[0] = v[sub][rr][0]; tp[1] = v[sub][rr][1]; tp[2] = v[sub][rr][2]; tp[3] = v[sub][rr][3]; } }
            __syncthreads();
            {   const int n = tid >> 3, kq = (tid & 7) * 8;
#pragma unroll
                for (int sub = 0; sub < 4; ++sub) { float e[8];
#pragma unroll
                    for (int i = 0; i < 8; ++i) e[i] = tile[sub * 4160 + (kq + i) * 65 + n];
                    store_bf8(dst + (size_t)(n0 + sub * 64 + n) * Kd + k0 + kq, e); } }
            __syncthreads();
        }
    }
    {   const size_t nth = (size_t)G * 512, gt = (size_t)c * 512 + tid;
        bf16_t* dch = (bf16_t*)(a.ws + WS_DCH); bf16_t* pctx = (bf16_t*)(a.ws + WS_PCTX); bf16_t* plat = (bf16_t*)(a.ws + WS_PLAT);
        for (size_t e = gt; e < 65536; e += nth) { const int r = (int)(e >> 6), c0 = (int)(e & 63) * 8, rr = r & 511; const bool sn = r >= 512; float v[8];
#pragma unroll
            for (int i = 0; i < 8; ++i) { const int p = (rr * (c0 + i)) & 511; const float ang = (float)p * (2.0f / 512.0f); v[i] = (sn ? sinpif(ang) : cospif(ang)) * 0.044194173824159216f; }
            store_bf8(dch + e * 8, v); }
        for (size_t e = gt; e < 16384; e += nth) { const int r = (int)(e >> 6), k0 = (int)(e & 63) * 8; const bool sn = k0 >= 256; float v[8];
#pragma unroll
            for (int i = 0; i < 8; ++i) { const int p = (r * ((k0 + i) & 255)) & 255; const float ang = (float)p * (2.0f / 256.0f); v[i] = (sn ? -sinpif(ang) : cospif(ang)) * 0.0625f; }
            store_bf8(pctx + e * 8, v); }
        bf16_t* ba = plat; bf16_t* ab = plat + (size_t)1024 * 1024;
        for (size_t e = gt; e < 131072; e += nth) { const int nn = (int)(e >> 7), k0 = (int)(e & 127) * 8; const int c2p = nn >> 4, comp = (nn >> 3) & 1, rl = nn & 7; float v[8];
#pragma unroll
            for (int i = 0; i < 8; ++i) { const int kk = k0 + i, rl2 = kk >> 7, part = (kk >> 6) & 1, c2 = kk & 63; const float ang = (float)((c2 * c2p) & 63) * (2.0f / 64.0f); const float cs = cospif(ang), sn = sinpif(ang);
                const float f = comp == 0 ? (part == 0 ? cs : -sn) : (part == 0 ? sn : cs); v[i] = rl == rl2 ? f * 0.125f : 0.f; }
            store_bf8(ba + e * 8, v); }
        for (size_t e = gt; e < 16384; e += nth) { const int ii = (int)(e >> 6), k0 = (int)(e & 63) * 8; const int c2l = ii >> 6, rp = ii & 63; float v[8];
#pragma unroll
            for (int i = 0; i < 8; ++i) { const int kk = k0 + i, c2l2 = kk >> 7, comp = (kk >> 6) & 1, r = kk & 63; const float ang = (float)((r * rp) & 63) * (2.0f / 64.0f);
                const float f = comp == 0 ? cospif(ang) : -sinpif(ang); v[i] = c2l == c2l2 ? f * 0.125f : 0.f; }
            store_bf8(ab + e * 8, v); }
    }
}

__device__ __forceinline__ void phase_h(const Args& a, const int G, const int c) {
    const int tid = fresh_tid(), wid = tid >> 6, lane = tid & 63;
    const float* modv = (const float*)(a.ws + WS_MODV); bf16_t* H = (bf16_t*)(a.ws + WS_H);
    for (int t = c * 8 + wid; t < T; t += G * 8) {
        const float* x = t < TC ? a.x_prompt + (size_t)t * 4096 : a.x_sample + (size_t)(t - TC) * 4096;
        const int bidx = t < TC ? 0 : 1 + ((t - TC) >> 12); const float* mv = modv + bidx * 12288;
        f32x4 v[16]; float ss = 0.f;
#pragma unroll
        for (int it = 0; it < 16; ++it) { v[it] = *(const f32x4*)(x + it * 256 + lane * 4); ss += v[it][0] * v[it][0] + v[it][1] * v[it][1] + v[it][2] * v[it][2] + v[it][3] * v[it][3]; }
        ss = wave_sum(ss); const float rstd = rsqrtf(ss * (1.0f / 4096.0f) + 1e-6f);
#pragma unroll
        for (int it = 0; it < 16; ++it) { const int col = it * 256 + lane * 4; const f32x4 nw = *(const f32x4*)(a.norm_w + col), sh = *(const f32x4*)(mv + col), sc = *(const f32x4*)(mv + 4096 + col);
            const f32x4 hv = v[it] * rstd * nw * (1.0f + sc) + sh; u32x2 w; w.x = cvt_pk_bf16(hv[0], hv[1]); w.y = cvt_pk_bf16(hv[2], hv[3]); *(u32x2*)(H + (size_t)t * 4096 + col) = w; }
    }
}
__device__ __forceinline__ void phase_glapost(const Args& a, const int G, const int c) {
    const int tid = fresh_tid(), wid = tid >> 6, lane = tid & 63;
    const bf16_t* OF = (const bf16_t*)(a.ws + WS_OF); const bf16_t* OB = (const bf16_t*)(a.ws + WS_OB); const bf16_t* GG = (const bf16_t*)(a.ws + WS_GG); bf16_t* MIX = (bf16_t*)(a.ws + WS_MIX);
    for (int task = c * 8 + wid; task < T * 4; task += G * 8) { const int t = task >> 2, h = task & 3, col = h * 512 + lane * 8;
        const u32x4 f = *(const u32x4*)(OF + (size_t)t * 2048 + col), b = *(const u32x4*)(OB + (size_t)t * 2048 + col), g = *(const u32x4*)(GG + (size_t)t * 2048 + col);
        float o[8]; o[0] = bflo(f.x) + bflo(b.x); o[1] = bfhi(f.x) + bfhi(b.x); o[2] = bflo(f.y) + bflo(b.y); o[3] = bfhi(f.y) + bfhi(b.y); o[4] = bflo(f.z) + bflo(b.z); o[5] = bfhi(f.z) + bfhi(b.z); o[6] = bflo(f.w) + bflo(b.w); o[7] = bfhi(f.w) + bfhi(b.w);
        float gg[8]; gg[0] = bflo(g.x); gg[1] = bfhi(g.x); gg[2] = bflo(g.y); gg[3] = bfhi(g.y); gg[4] = bflo(g.z); gg[5] = bfhi(g.z); gg[6] = bflo(g.w); gg[7] = bfhi(g.w);
        float ss = 0.f;
#pragma unroll
        for (int i = 0; i < 8; ++i) ss += o[i] * o[i];
        ss = wave_sum(ss); const float rstd = rsqrtf(ss * (1.0f / 512.0f) + 1e-6f);
        const f32x4 w0 = *(const f32x4*)(a.gla_norm_w + col), w1 = *(const f32x4*)(a.gla_norm_w + col + 4); float e[8];
#pragma unroll
        for (int i = 0; i < 8; ++i) e[i] = o[i] * rstd * (i < 4 ? w0[i & 3] : w1[i & 3]) * silu_f(gg[i]);
        store_bf8(MIX + (size_t)t * 4096 + 2048 + col, e); }
}
__device__ __forceinline__ void phase_final(const Args& a, const int G, const int c) {
    const int tid = fresh_tid(), wid = tid >> 6, lane = tid & 63;
    const float* modv = (const float*)(a.ws + WS_MODV); const bf16_t* OUTB = (const bf16_t*)(a.ws + WS_OF);
    for (int t = c * 8 + wid; t < T; t += G * 8) {
        const float* x = t < TC ? a.x_prompt + (size_t)t * 4096 : a.x_sample + (size_t)(t - TC) * 4096;
        const int bidx = t < TC ? 0 : 1 + ((t - TC) >> 12); const float* gt = modv + bidx * 12288 + 8192; float* y = a.out + (size_t)t * 4096;
        f32x4 v[16]; float ss = 0.f;
#pragma unroll
        for (int it = 0; it < 16; ++it) { const int col = it * 256 + lane * 4; const f32x4 xv = *(const f32x4*)(x + col); const f32x4 g = *(const f32x4*)(gt + col); const u32x2 ob = *(const u32x2*)(OUTB + (size_t)t * 4096 + col);
            v[it] = xv + g * (f32x4){bflo(ob.x), bfhi(ob.x), bflo(ob.y), bfhi(ob.y)}; ss += v[it][0] * v[it][0] + v[it][1] * v[it][1] + v[it][2] * v[it][2] + v[it][3] * v[it][3]; }
        ss = wave_sum(ss); const float rstd = rsqrtf(ss * (1.0f / 4096.0f) + 1e-6f);
#pragma unroll
        for (int it = 0; it < 16; ++it) { const int col = it * 256 + lane * 4; const f32x4 nw = *(const f32x4*)(a.final_norm_w + col); *(f32x4*)(y + col) = v[it] * rstd * nw; }
    }
}

__device__ __forceinline__ f32x4 mfma16(bf16x8 a, bf16x8 b, f32x4 c) { return __builtin_amdgcn_mfma_f32_16x16x32_bf16(a, b, c, 0, 0, 0); }
__device__ __forceinline__ unsigned short f2bf(float f) { return (unsigned short)(cvt_pk_bf16(f, 0.f) & 0xffffu); }
__device__ __forceinline__ void pre_decode(const int task, int& chunk, int& s, int& L, int& base) {
    if (task < 4096) { chunk = task & 63; s = task >> 6; L = 4096; base = TC + (s >> 3) * 4096; } else { const int t2 = task - 4096; chunk = t2 & 3; s = t2 >> 2; L = 256; base = (s >> 3) * 256; } }
__device__ __forceinline__ void phase_gla_pre(const Args& a, LAS unsigned char* lds, const int G, const int c) {
    constexpr int QS = 264;
    LAS bf16_t* QT = (LAS bf16_t*)(lds);
    LAS bf16_t* KT = (LAS bf16_t*)(lds + 33792);
    LAS bf16_t* KD = (LAS bf16_t*)(lds + 67584);
    LAS float* TOT = (LAS float*)(lds + 129024);
    LAS float* AL = (LAS float*)(lds + 131072);
    const int tid = fresh_tid(), k = tid & 255, half = __builtin_amdgcn_readfirstlane(tid >> 8);
    const bf16_t* Qb = (const bf16_t*)(a.ws + WS_Q); const bf16_t* Kb = (const bf16_t*)(a.ws + WS_K); const bf16_t* ABb = (const bf16_t*)(a.ws + WS_AB);
    const int per = (5120 + G - 1) / G, t_lo = c * per, t_hi = (t_lo + per) < 5120 ? (t_lo + per) : 5120;
    if (t_lo >= t_hi) return;
    u32x4 pq[4], pk[4], pa = (u32x4){0u, 0u, 0u, 0u};
#define PRE_LOAD(tk) do { int chunk_, s_, L_, base_; pre_decode((tk), chunk_, s_, L_, base_); const int dir_ = s_ & 1, h_ = (s_ >> 1) & 3, c0_ = chunk_ * 64; \
        _Pragma("unroll") for (int i = 0; i < 4; ++i) { const int id = tid + 512 * i, j = id >> 5, ch = id & 31; const int tok = base_ + (dir_ ? (L_ - 1 - (c0_ + j)) : (c0_ + j)); const size_t ro = (size_t)tok * 1024 + h_ * 256 + ch * 8; pq[i] = *(const u32x4*)(Qb + ro); pk[i] = *(const u32x4*)(Kb + ro); } \
        if (tid < 128) { const int j = tid >> 1, ch = tid & 1; const int tok = base_ + (dir_ ? (L_ - 1 - (c0_ + j)) : (c0_ + j)); pa = *(const u32x4*)(ABb + (size_t)tok * 32 + dir_ * 16 + ch * 8); } } while (0)
    PRE_LOAD(t_lo);
    int cur_s = -1; float wv[16]; float bias = 0.f;
#pragma unroll
    for (int r = 0; r < 16; ++r) wv[r] = 0.f;
    for (int task = t_lo; task < t_hi; ++task) {
        int chunk, s, L, base; pre_decode(task, chunk, s, L, base);
        const int dir = s & 1, h = (s >> 1) & 3, c0 = chunk * 64;
        if (s != cur_s) { cur_s = s;
#pragma unroll
            for (int r = 0; r < 16; ++r) wv[r] = a.w_alpha[(dir * 16 + r) * 1024 + h * 256 + k];
            bias = a.b_alpha[dir * 1024 + h * 256 + k]; }
#pragma unroll
        for (int i = 0; i < 4; ++i) { const int id = tid + 512 * i, j = id >> 5, ch = id & 31; *(LAS u32x4*)(QT + j * QS + ch * 8) = pq[i]; *(LAS u32x4*)(KT + j * QS + ch * 8) = pk[i]; }
        if (tid < 128) { const int j = tid >> 1, ch = tid & 1; LAS float* ap = AL + j * 16 + ch * 8;
            *(LAS f32x4*)ap = (f32x4){bflo(pa.x), bfhi(pa.x), bflo(pa.y), bfhi(pa.y)}; *(LAS f32x4*)(ap + 4) = (f32x4){bflo(pa.z), bfhi(pa.z), bflo(pa.w), bfhi(pa.w)}; }
        { const int nx = task + 1 < t_hi ? task + 1 : task; PRE_LOAD(nx); }
        __syncthreads();
        float bc[32]; float cum = 0.f;
#pragma unroll
        for (int jj = 0; jj < 32; ++jj) { const int j = half * 32 + jj;
            const f32x4 a0 = *(const LAS f32x4*)(AL + j * 16), a1 = *(const LAS f32x4*)(AL + j * 16 + 4), a2 = *(const LAS f32x4*)(AL + j * 16 + 8), a3 = *(const LAS f32x4*)(AL + j * 16 + 12);
            float pre = bias;
#pragma unroll
            for (int r = 0; r < 4; ++r) pre += a0[r] * wv[r] + a1[r] * wv[4 + r] + a2[r] * wv[8 + r] + a3[r] * wv[12 + r];
            const float ls = fminf(pre, 0.f) - __logf(1.0f + __expf(-fabsf(pre)));
            cum += ls * 0.0625f; bc[jj] = cum; }
        TOT[half * 256 + k] = cum;
        __syncthreads();
        const float t0 = TOT[k], t1 = TOT[256 + k]; const float off = half ? t0 : 0.f; const float bl = t0 + t1;
        if (half == 0) ((float*)(a.ws + WS_DECG))[((size_t)dir * (T / 64) + ((base + c0) >> 6)) * 1024 + h * 256 + k] = __expf(bl);
#pragma unroll
        for (int jj = 0; jj < 32; ++jj) { const int j = half * 32 + jj; const float qv = bf2f(QT[j * QS + k]), kv = bf2f(KT[j * QS + k]); const float bb = bc[jj] + off;
            QT[j * QS + k] = f2bf(qv * __expf(bb) * 0.0625f); KT[j * QS + k] = f2bf(kv * __expf(-bb)); KD[j * QS + k] = f2bf(kv * __expf(bl - bb)); }
        __syncthreads();
        {   bf16_t* qg = (bf16_t*)(a.ws + WS_QTG) + (size_t)dir * T * 1024; bf16_t* kg = (bf16_t*)(a.ws + WS_KTG) + (size_t)dir * T * 1024; bf16_t* dg = (bf16_t*)(a.ws + WS_KDG) + (size_t)dir * T * 1024;
#pragma unroll
            for (int i = 0; i < 4; ++i) { const int id = tid + 512 * i, j = id >> 5, ch = id & 31; const size_t ro = (size_t)(base + c0 + j) * 1024 + h * 256 + ch * 8;
                *(u32x4*)(qg + ro) = *(const LAS u32x4*)(QT + j * QS + ch * 8); *(u32x4*)(kg + ro) = *(const LAS u32x4*)(KT + j * QS + ch * 8); *(u32x4*)(dg + ro) = *(const LAS u32x4*)(KD + j * QS + ch * 8); } }
        __syncthreads();
    }
#undef PRE_LOAD
}
typedef short s16x4 __attribute__((ext_vector_type(4)));
__device__ __forceinline__ bf16x8 tr_read8(const LAS bf16_t* p0, const int stride_el) {
    const s16x4 lo = __builtin_amdgcn_ds_read_tr16_b64_v4i16((LAS s16x4*)p0), hi = __builtin_amdgcn_ds_read_tr16_b64_v4i16((LAS s16x4*)(p0 + 4 * stride_el));
    return __builtin_shufflevector(lo, hi, 0, 1, 2, 3, 4, 5, 6, 7); }
__device__ __forceinline__ void phase_gla(const Args& a, LAS unsigned char* lds, const int G, const int c) {
    constexpr int QS = 264, VS = 136, KS = 72;
    LAS bf16_t* QT = (LAS bf16_t*)(lds);
    LAS bf16_t* KT = (LAS bf16_t*)(lds + 33792);
    LAS bf16_t* KD = (LAS bf16_t*)(lds + 67584);
    LAS bf16_t* VR = (LAS bf16_t*)(lds + 101376);
    LAS bf16_t* ATT = (LAS bf16_t*)(lds + 118784);
    LAS float* DEC = (LAS float*)(lds + 128000);
    const int tid = fresh_tid(), w = __builtin_amdgcn_readfirstlane(tid >> 6), lane = tid & 63, n = lane & 15, q = lane >> 4;
    const int trq = (lane & 15) >> 2, trp = lane & 3;
    const bf16_t* Vb = (const bf16_t*)(a.ws + WS_V);
    for (int u = c; u < 256 + 1024; u += G) {
        const bool lat = u < 256; const int uu = lat ? u : u - 256;
        const int sl = (uu & 7) * 8 + (((uu & 255) >> 3) >> 2), vs = ((uu & 255) >> 3) & 3, s = (uu >> 8) * 64 + sl;
        const int dir = s & 1, h = (s >> 1) & 3, b = s >> 3;
        const int L = lat ? 4096 : 256, base = lat ? TC + b * 4096 : b * 256, nsteps = L >> 6;
        f32x4 S[16];
        if (lat) { const float* sp = (dir ? a.st_b : a.st_f) + ((size_t)(b * 4 + h) * 256) * 512 + vs * 128 + w * 16 + n;
#pragma unroll
            for (int t = 0; t < 16; ++t)
#pragma unroll
                for (int r = 0; r < 4; ++r) S[t][r] = sp[(size_t)(t * 16 + 4 * q + r) * 512]; }
        else {
#pragma unroll
            for (int t = 0; t < 16; ++t) S[t] = (f32x4){0.f, 0.f, 0.f, 0.f}; }
        bf16_t* OX = (bf16_t*)(a.ws + (dir ? WS_OB : WS_OF));
        const bf16_t* qg = (const bf16_t*)(a.ws + WS_QTG) + (size_t)dir * T * 1024 + h * 256; const bf16_t* kg = (const bf16_t*)(a.ws + WS_KTG) + (size_t)dir * T * 1024 + h * 256; const bf16_t* dg = (const bf16_t*)(a.ws + WS_KDG) + (size_t)dir * T * 1024 + h * 256;
        const float* decg = (const float*)(a.ws + WS_DECG) + (size_t)dir * (T / 64) * 1024 + h * 256;
#define TOKC(cj) (base + (dir ? (L - 1 - (cj)) : (cj)))
        u32x4 pq[4], pk[4], pd[4], pv[2], pe;
#define GLA_LOAD(stp) do { const int cc0 = (stp) * 64; \
            _Pragma("unroll") for (int i = 0; i < 4; ++i) { const int id = tid + 512 * i, j = id >> 5, ch = id & 31; const size_t ro = (size_t)(base + cc0 + j) * 1024 + ch * 8; pq[i] = *(const u32x4*)(qg + ro); pk[i] = *(const u32x4*)(kg + ro); pd[i] = *(const u32x4*)(dg + ro); } \
            _Pragma("unroll") for (int i = 0; i < 2; ++i) { const int id = tid + 512 * i, j = id >> 4, ch = id & 15; pv[i] = *(const u32x4*)(Vb + (size_t)TOKC(cc0 + j) * 2048 + h * 512 + vs * 128 + ch * 8); } \
            if (tid < 64) pe = *(const u32x4*)(decg + (size_t)((base + cc0) >> 6) * 1024 + tid * 4); } while (0)
        pe = (u32x4){0u, 0u, 0u, 0u};
        GLA_LOAD(0);
        for (int step = 0; step < nsteps; ++step) {
            const int c0 = step * 64;
#pragma unroll
            for (int i = 0; i < 4; ++i) { const int id = tid + 512 * i, j = id >> 5, ch = id & 31; *(LAS u32x4*)(QT + j * QS + ch * 8) = pq[i]; *(LAS u32x4*)(KT + j * QS + ch * 8) = pk[i]; *(LAS u32x4*)(KD + j * QS + ch * 8) = pd[i]; }
#pragma unroll
            for (int i = 0; i < 2; ++i) { const int id = tid + 512 * i, j = id >> 4, ch = id & 15; *(LAS u32x4*)(VR + j * VS + ch * 8) = pv[i]; }
            if (tid < 64) *(LAS u32x4*)(DEC + tid * 4) = pe;
            { const int ns = step + 1 < nsteps ? step + 1 : step; GLA_LOAD(ns); }
            __syncthreads();
#pragma unroll
            for (int tt = 0; tt < 2; ++tt) { const int id = w * 2 + tt, jt = id >> 2, it = id & 3; f32x4 acc = (f32x4){0.f, 0.f, 0.f, 0.f};
                if (jt <= it) {
#pragma unroll
                    for (int ks = 0; ks < 8; ++ks) { const bf16x8 A = *(const LAS bf16x8*)(KT + (jt * 16 + n) * QS + ks * 32 + 8 * q); const bf16x8 B = *(const LAS bf16x8*)(QT + (it * 16 + n) * QS + ks * 32 + 8 * q); acc = mfma16(A, B, acc); }
#pragma unroll
                    for (int r = 0; r < 4; ++r) if (jt * 16 + 4 * q + r > it * 16 + n) acc[r] = 0.f; }
                u32x2 pk2; pk2.x = cvt_pk_bf16(acc[0], acc[1]); pk2.y = cvt_pk_bf16(acc[2], acc[3]);
                *(LAS u32x2*)(ATT + (it * 16 + n) * KS + jt * 16 + 4 * q) = pk2; }
            f32x4 o[4];
#pragma unroll
            for (int mt = 0; mt < 4; ++mt) o[mt] = (f32x4){0.f, 0.f, 0.f, 0.f};
#pragma unroll
            for (int kb = 0; kb < 8; ++kb) { u32x4 bs; bs.x = cvt_pk_bf16(S[2 * kb][0], S[2 * kb][1]); bs.y = cvt_pk_bf16(S[2 * kb][2], S[2 * kb][3]); bs.z = cvt_pk_bf16(S[2 * kb + 1][0], S[2 * kb + 1][1]); bs.w = cvt_pk_bf16(S[2 * kb + 1][2], S[2 * kb + 1][3]);
                const bf16x8 Bs = __builtin_bit_cast(bf16x8, bs);
#pragma unroll
                for (int mt = 0; mt < 4; ++mt) { const u32x2 lo = *(const LAS u32x2*)(QT + (mt * 16 + n) * QS + kb * 32 + 4 * q), hi = *(const LAS u32x2*)(QT + (mt * 16 + n) * QS + kb * 32 + 16 + 4 * q);
                    u32x4 av; av.x = lo.x; av.y = lo.y; av.z = hi.x; av.w = hi.y; o[mt] = mfma16(__builtin_bit_cast(bf16x8, av), Bs, o[mt]); } }
            __syncthreads();
            bf16x8 Bv[2];
#pragma unroll
            for (int js = 0; js < 2; ++js) Bv[js] = tr_read8(VR + (js * 32 + 8 * q + trq) * VS + w * 16 + 4 * trp, VS);
#pragma unroll
            for (int mt = 0; mt < 4; ++mt)
#pragma unroll
                for (int js = 0; js < 2; ++js) { const bf16x8 A = *(const LAS bf16x8*)(ATT + (mt * 16 + n) * KS + js * 32 + 8 * q); o[mt] = mfma16(A, Bv[js], o[mt]); }
#pragma unroll
            for (int mt = 0; mt < 4; ++mt)
#pragma unroll
                for (int r = 0; r < 4; ++r) OX[(size_t)TOKC(c0 + mt * 16 + 4 * q + r) * 2048 + h * 512 + vs * 128 + w * 16 + n] = f2bf(o[mt][r]);
#pragma unroll
            for (int t = 0; t < 16; ++t) { const f32x4 dc = *(const LAS f32x4*)(DEC + t * 16 + 4 * q); S[t] = S[t] * dc;
#pragma unroll
                for (int js = 0; js < 2; ++js) { const bf16x8 A = tr_read8(KD + (js * 32 + 8 * q + trq) * QS + t * 16 + 4 * trp, QS); S[t] = mfma16(A, Bv[js], S[t]); } }
            __syncthreads();
        }
#undef GLA_LOAD
#undef TOKC
        if (!lat) { float* sp = a.out + (size_t)167772160 + (dir ? (size_t)16777216 : (size_t)0) + ((size_t)(b * 4 + h) * 256) * 512 + vs * 128 + w * 16 + n;
#pragma unroll
            for (int t = 0; t < 16; ++t)
#pragma unroll
                for (int r = 0; r < 4; ++r) sp[(size_t)(t * 16 + 4 * q + r) * 512] = S[t][r]; }
    }
}

#ifndef PH_LO
#define PH_LO 0
#endif
#ifndef PH_HI
#define PH_HI 10
#endif
__global__ __launch_bounds__(512, 2) void mega(Args a) {
    extern __shared__ __attribute__((aligned(16))) unsigned char shm[];
    LAS unsigned char* lds = (LAS unsigned char*)shm;
    const int tid = fresh_tid(), G = gridDim.x, c = blockIdx.x;
    volatile LAS unsigned* st = (volatile LAS unsigned*)(lds + LDS_BARW);
    if (tid < 4) st[tid] = 0u;
    __syncthreads();
    XcdBarrier bar = xcd_barrier_post((unsigned*)(a.ws + WS_CTL), st);
    unsigned char* ws = a.ws;
    phase0(a, lds, G, c);
    xcd_barrier(bar);
    phase_h(a, G, c);
    xcd_barrier(bar);
    {
        BOrder S; S.nM = 160; S.nN = 41; S.nB = 1; S.nB2 = 1; S.G = G; S.c = c; S.nsplit = S.nN; S.aN = 0; S.bM = 0; S.A = (const char*)(ws + WS_H); S.B = (const char*)(ws + WS_WINT); S.sA1 = S.sA2 = S.sB1 = S.sB2 = 0; S.tA = (size_t)256 * 4096 * 2; S.tB = (size_t)256 * 4096 * 2;
        EpiB<DstInProj, false> E; E.f.ws = ws; pg8::gemm_phase(lds, 4096, 4096, 4096, S, E);
#if defined(PROBE_DUP_INPROJ)
        __syncthreads(); pg8::gemm_phase(lds, 4096, 4096, 4096, S, E);
#endif
    }
    xcd_barrier(bar);
    {
        BOrder S; S.nM = 4; S.nN = 160; S.nB = 4; S.nB2 = 1; S.G = G; S.c = c; S.nsplit = S.nN; S.aN = 0; S.bM = 0; S.A = (const char*)(ws + WS_DCH); S.B = (const char*)(ws + WS_FIN); S.sA1 = 0; S.sA2 = 0; S.sB1 = 1024; S.sB2 = 0; S.tA = (size_t)256 * 512 * 2; S.tB = (size_t)256 * 2048 * 2;
        EpiB<DstChDft, false> E; E.f.ws = ws; pg8::gemm_phase(lds, 512, 2048, 512, S, E); }
    xcd_barrier(bar);
    {
        BOrder S; S.nM = 1; S.nN = 2; S.nB = 128; S.nB2 = 4; S.G = G; S.c = c; S.nsplit = S.nN; S.aN = 0; S.bM = 0; S.A = (const char*)(ws + WS_PCTX); S.B = (const char*)(ws + WS_ZTC); S.sA1 = 0; S.sA2 = 0; S.sB1 = 1024; S.sB2 = (size_t)512 * 16384 * 2; S.tA = (size_t)256 * 512 * 2; S.tB = (size_t)256 * 16384 * 2;
        EpiB<DstPosCtx, false> E; E.f.ws = ws; pg8::gemm_phase(lds, 512, 16384, 512, S, E); }
    {
        BOrder S; S.nM = 64; S.nN = 32; S.nB = 1; S.nB2 = 1; S.G = G; S.c = c; S.nsplit = 4; S.aN = 2048; S.bM = 0; S.A = (const char*)(ws + WS_ZTL); S.B = (const char*)(ws + WS_PLAT); S.sA1 = S.sA2 = S.sB1 = S.sB2 = 0; S.tA = (size_t)256 * 8192 * 2; S.tB = (size_t)256 * 1024 * 2;
        EpiB<DstLatA, false> E; E.f.ws = ws; pg8::gemm_phase(lds, 8192, 1024, 1024, S, E); }
    xcd_barrier(bar);
    {
        BOrder S; S.nM = 16; S.nN = 2; S.nB = 32; S.nB2 = 4; S.G = G; S.c = c; S.nsplit = 2; S.aN = 0; S.bM = 1024; S.A = (const char*)(ws + WS_PLAT + (size_t)1024 * 1024 * 2); S.B = (const char*)(ws + WS_OF); S.sA1 = 0; S.sA2 = 0; S.sB1 = 16384; S.sB2 = (size_t)512 * 65536 * 2; S.tA = 0; S.tB = (size_t)256 * 65536 * 2;
        EpiB<DstLatB, false> E; E.f.ws = ws; pg8::gemm_phase(lds, 512, 65536, 512, S, E); }
    xcd_barrier(bar);
    {
        BOrder S; S.nM = 160; S.nN = 2; S.nB = 4; S.nB2 = 1; S.G = G; S.c = c; S.nsplit = S.nN; S.aN = 0; S.bM = 0; S.A = (const char*)(ws + WS_RE); S.B = (const char*)(ws + WS_WFT); S.sA1 = 1024; S.sA2 = 0; S.sB1 = (size_t)512 * 512 * 2; S.sB2 = 0; S.tA = (size_t)256 * 2048 * 2; S.tB = (size_t)256 * 512 * 2;
        EpiB<DstWf, true> E; E.f.ws = ws; pg8::gemm_phase(lds, 2048, 512, 512, S, E); }
    xcd_barrier(bar);
    phase_gla_pre(a, lds, G, c);
#if defined(PROBE_DUP_PRE)
    __syncthreads(); phase_gla_pre(a, lds, G, c);
#endif
    xcd_barrier(bar);
    phase_gla(a, lds, G, c);
#if defined(PROBE_DUP_GLA)
    __syncthreads(); phase_gla(a, lds, G, c);
#endif
    xcd_barrier(bar);
    phase_glapost(a, G, c);
    xcd_barrier(bar);
    {
        BOrder S; S.nM = 160; S.nN = 16; S.nB = 1; S.nB2 = 1; S.G = G; S.c = c; S.nsplit = S.nN; S.aN = 0; S.bM = 0; S.A = (const char*)(ws + WS_MIX); S.B = (const char*)(ws + WS_WOUTT); S.sA1 = S.sA2 = S.sB1 = S.sB2 = 0; S.tA = (size_t)256 * 4096 * 2; S.tB = (size_t)256 * 4096 * 2;
        EpiB<DstOut, false> E; E.f.ws = ws; pg8::gemm_phase(lds, 4096, 4096, 4096, S, E); }
    xcd_barrier(bar);
    phase_final(a, G, c);
}

extern "C" void kernel_launch(void* const* d_in, const int* in_sizes, int n_in, void* d_out, int out_size, void* d_ws, size_t ws_size, hipStream_t stream) {
    static int grid = 0;
    if (grid == 0) {
        int dev = 0, cus = 0, per_cu = 0;
        if (n_in != 16 || ws_size < WS_END) { grid = -1; return; }
        if (hipGetDevice(&dev) != hipSuccess || hipDeviceGetAttribute(&cus, hipDeviceAttributeMultiprocessorCount, dev) != hipSuccess) { grid = -1; return; }
        if (hipFuncSetAttribute((const void*)mega, hipFuncAttributeMaxDynamicSharedMemorySize, LDS_BYTES) != hipSuccess) { grid = -1; return; }
        if (hipOccupancyMaxActiveBlocksPerMultiprocessor(&per_cu, (const void*)mega, 512, LDS_BYTES) != hipSuccess || per_cu < 1) { (void)hipGetLastError(); per_cu = 1; }
        grid = cus;
        if (grid > 256) grid = 256;
    }
    if (grid < 0) return;
    (void)hipMemsetAsync((char*)d_ws + WS_CTL, 0, WS_ZERO_BYTES, stream);
    Args a{};
    a.x_prompt = (const float*)d_in[0]; a.x_sample = (const float*)d_in[1]; a.st_f = (const float*)d_in[2]; a.st_b = (const float*)d_in[3]; a.c = (const float*)d_in[4]; a.c_ctx = (const float*)d_in[5];
    a.ada_w = (const float*)d_in[6]; a.ada_b = (const float*)d_in[7]; a.norm_w = (const float*)d_in[8]; a.w_in = (const float*)d_in[9]; a.w_alpha = (const float*)d_in[10]; a.b_alpha = (const float*)d_in[11];
    a.w_fourier = (const float*)d_in[12]; a.gla_norm_w = (const float*)d_in[13]; a.w_out = (const float*)d_in[14]; a.final_norm_w = (const float*)d_in[15];
    a.out = (float*)d_out; a.ws = (unsigned char*)d_ws;
    hipLaunchKernelGGL(mega, dim3(grid), dim3(512), LDS_BYTES, stream, a);
}
```
